# Optimizing an MI355X kernel written in HIP

```python
import math
import jax
import jax.numpy as jnp
from jax import lax
import numpy as np

D_MODEL = 1024
BATCH = 32
SEQ = 2048
DEPTH = 2

GRID_W = 64
CTX_LEN = 256
N_MOD = 9
D_FF = 2816
FFN_HALF = 0.5
ALPHA = (2 * DEPTH) ** 0.25
BETA = (8 * DEPTH) ** -0.25
N_BRANCH = 4
BRANCH_W = 256
NA_HEADS = 4
NA_DH = 64
NA_KH_MAX = 8
NA_KW = 16
ML_HEADS = 4
ML_DQK = 64
ML_DV = 64
ML_CHUNK = 64
ML_F_BIAS = 3.0
GLA_HEADS = 4
GLA_DK = 32
GLA_DV = 64
GLA_RANK = 16
GLA_TAU = 16.0
GLA_CHUNK = 16
DA_HEADS = 4
DA_DQK = 32
DA_DV = 64
DA_QBLOCK = 128
ROPE_BASE = 10000.0

COLS = (
    ("na_q", NA_HEADS * NA_DH), ("na_k", NA_HEADS * NA_DH), ("na_v", NA_HEADS * NA_DH),
    ("ml_q", ML_HEADS * ML_DQK), ("ml_k", ML_HEADS * ML_DQK), ("ml_v", ML_HEADS * ML_DV),
    ("ml_o", ML_HEADS * ML_DV), ("ml_if", 4 * ML_HEADS),
    ("gla_q", GLA_HEADS * GLA_DK), ("gla_k", GLA_HEADS * GLA_DK), ("gla_v", GLA_HEADS * GLA_DV),
    ("gla_g", GLA_HEADS * GLA_DV), ("gla_a", 2 * GLA_RANK),
    ("da_q", DA_HEADS * 2 * DA_DQK), ("da_k", DA_HEADS * 2 * DA_DQK), ("da_v", DA_HEADS * DA_DV),
    ("gates", N_BRANCH * D_MODEL),
)
N_COLS = sum(w for _, w in COLS)

kernel_name = "hybrid_dit_na_mlstm_gla_diffattn"


def _layer_norm(x, g, b, eps=1e-5):
    xf = x.astype(jnp.float32)
    mu = jnp.mean(xf, axis=-1, keepdims=True)
    var = jnp.mean(jnp.square(xf - mu), axis=-1, keepdims=True)
    return ((xf - mu) * lax.rsqrt(var + eps) * g + b).astype(x.dtype)


def _modulate(x, shift, scale):
    return x * (1 + scale) + shift


def _swiglu(h, w_in, w_out):
    a, b = jnp.split(h @ w_in, 2, axis=-1)
    return (jax.nn.silu(a) * b) @ w_out


def _heads(t, n):
    B, S, W = t.shape
    return t.reshape(B, S, n, W // n).transpose(0, 2, 1, 3)


def _merge(t):
    B, H, S, d = t.shape
    return t.transpose(0, 2, 1, 3).reshape(B, S, H * d)


def _to_chunks(t, size):
    B, H, S = t.shape[:3]
    return jnp.moveaxis(t.reshape(B, H, S // size, size, *t.shape[3:]), 2, 0)


def _from_chunks(t):
    nc, B, H, size = t.shape[:4]
    return jnp.moveaxis(t, 0, 2).reshape(B, H, nc * size, *t.shape[4:])


def _head_norm(y, g, center, eps=1e-6):
    yf = y.astype(jnp.float32)
    if center:
        yf = yf - jnp.mean(yf, axis=-1, keepdims=True)
    yf = yf * lax.rsqrt(jnp.mean(jnp.square(yf), axis=-1, keepdims=True) + eps)
    return _merge(yf) * g


def _split_cols(p):
    out, off = {}, 0
    for name, w in COLS:
        out[name] = p[..., off:off + w]
        off += w
    return out


def _dense_attention(q, k, v):
    s = jnp.einsum("bhqd,bhkd->bhqk", q, k).astype(jnp.float32) * q.shape[-1] ** -0.5
    return jnp.einsum("bhqk,bhkd->bhqd", jax.nn.softmax(s, axis=-1).astype(v.dtype), v)


def _neighbourhood_attention(q, k, v, qc, kc, vc, rpb, rows, ctx_out):
    B, H, S, d = q.shape
    kh = min(NA_KH_MAX, rows)
    scale = d ** -0.5
    qg = q.reshape(B, H, rows, GRID_W, d)
    kg = k.reshape(B, H, rows, GRID_W, d)
    vg = v.reshape(B, H, rows, GRID_W, d)
    col = jnp.arange(GRID_W)
    c0 = jnp.clip(col - NA_KW // 2, 0, GRID_W - NA_KW)
    col_ok = (col[None, :] >= c0[:, None]) & (col[None, :] < c0[:, None] + NA_KW)
    dc_idx = jnp.clip(col[None, :] - col[:, None] + NA_KW - 1, 0, 2 * NA_KW - 2)
    n_loc = kh * GRID_W

    def row_block(r):
        r0 = jnp.clip(r - kh // 2, 0, rows - kh)
        k_blk = lax.dynamic_slice_in_dim(kg, r0, kh, axis=2)
        v_blk = lax.dynamic_slice_in_dim(vg, r0, kh, axis=2)
        q_row = lax.dynamic_index_in_dim(qg, r, axis=2, keepdims=False)
        dr_idx = r0 + jnp.arange(kh) - r + NA_KH_MAX - 1
        bias = rpb[:, dr_idx[None, :, None], dc_idx[:, None, :]]
        s_loc = jnp.einsum("bhqd,bhrkd->bhqrk", q_row, k_blk).astype(jnp.float32) * scale + bias
        s_loc = jnp.where(col_ok[:, None, :], s_loc, -jnp.inf).reshape(B, H, GRID_W, n_loc)
        s_ctx = jnp.einsum("bhqd,bhtd->bhqt", q_row, kc).astype(jnp.float32) * scale
        p = jax.nn.softmax(jnp.concatenate([s_loc, s_ctx], axis=-1), axis=-1).astype(v.dtype)
        p_loc = p[..., :n_loc].reshape(B, H, GRID_W, kh, GRID_W)
        return (jnp.einsum("bhqrk,bhrkd->bhqd", p_loc, v_blk)
                + jnp.einsum("bhqt,bhtd->bhqd", p[..., n_loc:], vc))

    out = _from_chunks(lax.map(row_block, jnp.arange(rows)))
    outc = _dense_attention(qc, kc, vc) if ctx_out else None
    return out, outc


def _mlstm_scan(q, k, v, log_i, log_f, state):
    L = ML_CHUNK
    mask = jnp.tril(jnp.ones((L, L), dtype=bool))

    def step(carry, inp):
        c_mat, n_vec, m_prev = carry
        qb, kb, vb, ib, fb = inp
        b = jnp.cumsum(fb, axis=-1)
        d_log = jnp.where(mask, b[..., :, None] - b[..., None, :] + ib[..., None, :], -jnp.inf)
        inter = b + m_prev[..., None]
        m_t = jnp.maximum(inter, jnp.max(d_log, axis=-1))
        w = jnp.exp(d_log - m_t[..., None])
        w_inter = jnp.exp(inter - m_t)
        qk = jnp.einsum("bhtd,bhsd->bhts", qb, kb) * w
        num = (jnp.einsum("bhts,bhsv->bhtv", qk, vb)
               + w_inter[..., None] * jnp.einsum("bhtd,bhdv->bhtv", qb, c_mat))
        den = jnp.sum(qk, axis=-1) + w_inter * jnp.einsum("bhtd,bhd->bht", qb, n_vec)
        h = num / jnp.maximum(jnp.abs(den), jnp.exp(-m_t))[..., None]
        b_end = b[..., -1]
        k_log = b_end[..., None] - b + ib
        m_new = jnp.maximum(b_end + m_prev, jnp.max(k_log, axis=-1))
        wk = jnp.exp(k_log - m_new[..., None])
        decay = jnp.exp(b_end + m_prev - m_new)
        c_mat = decay[..., None, None] * c_mat + jnp.einsum("bhsd,bhsv->bhdv", kb * wk[..., None], vb)
        n_vec = decay[..., None] * n_vec + jnp.einsum("bhs,bhsd->bhd", wk, kb)
        return (c_mat, n_vec, m_new), h

    xs = tuple(_to_chunks(t, L) for t in (q, k, v, log_i, log_f))
    state, hs = lax.scan(step, state, xs)
    return _from_chunks(hs), state


def _gla_scan(q, k, v, log_a, state):
    L = GLA_CHUNK
    mask = jnp.tril(jnp.ones((L, L), dtype=bool))

    def step(st, inp):
        qb, kb, vb, ab = inp
        b = jnp.cumsum(ab, axis=2)
        rel = jnp.where(mask[:, :, None], b[:, :, :, None, :] - b[:, :, None, :, :], -jnp.inf)
        att = jnp.einsum("bhtd,bhsd,bhtsd->bhts", qb, kb, jnp.exp(rel))
        o = jnp.einsum("bhts,bhsv->bhtv", att, vb) + jnp.einsum("bhtd,bhdv->bhtv", qb * jnp.exp(b), st)
        b_end = b[:, :, -1:, :]
        st = (jnp.exp(b_end[:, :, 0, :])[..., None] * st
              + jnp.einsum("bhsd,bhsv->bhdv", kb * jnp.exp(b_end - b), vb))
        return st, o

    xs = tuple(_to_chunks(t, L) for t in (q, k, v, log_a))
    state, os_ = lax.scan(step, state, xs)
    return _from_chunks(os_), state


def _flip(ts):
    return tuple(jnp.flip(t, axis=2) for t in ts)


def _bidirectional(scan, lat_f, lat_b, ctx_f, ctx_b, init):
    hc_f, st_f = scan(*ctx_f, init)
    h_f, _ = scan(*lat_f, st_f)
    hc_b, st_b = scan(*_flip(ctx_b), init)
    h_b, _ = scan(*_flip(lat_b), st_b)
    return h_f + jnp.flip(h_b, axis=2), hc_f + jnp.flip(hc_b, axis=2)


def _axial_rope_tables(S, dim, dtype):
    t = jnp.arange(S)
    n_f = dim // 4
    inv = ROPE_BASE ** (-jnp.arange(n_f, dtype=jnp.float32) / n_f)

    def cs(pos):
        ang = pos.astype(jnp.float32)[:, None] * inv
        return jnp.cos(ang).astype(dtype), jnp.sin(ang).astype(dtype)

    return cs(t // GRID_W), cs(t % GRID_W)


def _rotate(y, cos, sin):
    y1, y2 = jnp.split(y, 2, axis=-1)
    return jnp.concatenate([y1 * cos - y2 * sin, y1 * sin + y2 * cos], axis=-1)


def _rope_2d(x, row_cs, col_cs):
    xr, xc = jnp.split(x, 2, axis=-1)
    return jnp.concatenate([_rotate(xr, *row_cs), _rotate(xc, *col_cs)], axis=-1)


def _diff_map(q1, q2, k1, k2, v, lam):
    scale = DA_DQK ** -0.5
    a1 = jax.nn.softmax(jnp.einsum("bhqd,bhkd->bhqk", q1, k1).astype(jnp.float32) * scale, axis=-1)
    a2 = jax.nn.softmax(jnp.einsum("bhqd,bhkd->bhqk", q2, k2).astype(jnp.float32) * scale, axis=-1)
    return jnp.einsum("bhqk,bhkd->bhqd", (a1 - lam * a2).astype(v.dtype), v)


def _diff_attention(q1, q2, k1, k2, v, q1c, q2c, k1c, k2c, vc, lam, ctx_out):
    S = q1.shape[2]
    k1a = jnp.concatenate([k1, k1c], axis=2)
    k2a = jnp.concatenate([k2, k2c], axis=2)
    va = jnp.concatenate([v, vc], axis=2)

    def block(i):
        s0 = i * DA_QBLOCK
        return _diff_map(lax.dynamic_slice_in_dim(q1, s0, DA_QBLOCK, axis=2),
                         lax.dynamic_slice_in_dim(q2, s0, DA_QBLOCK, axis=2), k1a, k2a, va, lam)

    out = _from_chunks(lax.map(block, jnp.arange(S // DA_QBLOCK)))
    outc = _diff_map(q1c, q2c, k1c, k2c, vc, lam) if ctx_out else None
    return out, outc


def _prep(p, ml_gate_b, gla_w_a2, gla_b_a):
    f32 = jnp.float32
    P = _split_cols(p)
    g = (P["ml_if"] + ml_gate_b).astype(f32)
    i_f, f_f, i_b, f_b = [t.transpose(0, 2, 1) for t in jnp.split(g, 4, axis=-1)]
    f_f, f_b = jax.nn.log_sigmoid(f_f), jax.nn.log_sigmoid(f_b)
    mq = _heads(P["ml_q"], ML_HEADS).astype(f32) * ML_DQK ** -0.5
    mk = _heads(P["ml_k"], ML_HEADS).astype(f32)
    mv = _heads(P["ml_v"], ML_HEADS).astype(f32)
    gq = _heads(P["gla_q"], GLA_HEADS).astype(f32) * GLA_DK ** -0.5
    gk = _heads(P["gla_k"], GLA_HEADS).astype(f32)
    gv = _heads(P["gla_v"], GLA_HEADS).astype(f32)
    a_f, a_b = jnp.split(P["gla_a"], 2, axis=-1)

    def decay(a, j):
        return _heads(jax.nn.log_sigmoid((a @ gla_w_a2[j] + gla_b_a[j]).astype(f32)) / GLA_TAU, GLA_HEADS)

    dq1, dq2 = jnp.split(_heads(P["da_q"], DA_HEADS), 2, axis=-1)
    dk1, dk2 = jnp.split(_heads(P["da_k"], DA_HEADS), 2, axis=-1)
    return {
        "na": (_heads(P["na_q"], NA_HEADS), _heads(P["na_k"], NA_HEADS), _heads(P["na_v"], NA_HEADS)),
        "ml_f": (mq, mk, mv, i_f, f_f),
        "ml_b": (mq, mk, mv, i_b, f_b),
        "ml_o": P["ml_o"],
        "gla_f": (gq, gk, gv, decay(a_f, 0)),
        "gla_b": (gq, gk, gv, decay(a_b, 1)),
        "gla_g": P["gla_g"],
        "da": (dq1, dq2, dk1, dk2, _heads(P["da_v"], DA_HEADS)),
        "gates": P["gates"],
    }


def _merge_branches(ys, gates, w_branch, w_out):
    g = jnp.split(gates, N_BRANCH, axis=-1)
    acc = jax.nn.sigmoid(g[0]) * (ys[0] @ w_branch[0])
    for j in range(1, N_BRANCH):
        acc = acc + jax.nn.sigmoid(g[j]) * (ys[j] @ w_branch[j])
    return acc @ w_out


def _token_mixer(h, hc, ctx_out, w_mix_in, na_rpb, ml_gate_b, ml_norm_g, gla_w_a2, gla_b_a,
                 gla_norm_g, da_lambda, da_norm_g, lambda_init, w_branch, w_out):
    B, S, _ = h.shape
    rows = S // GRID_W
    dt = h.dtype
    lt = _prep(h @ w_mix_in, ml_gate_b, gla_w_a2, gla_b_a)
    cx = _prep(hc @ w_mix_in, ml_gate_b, gla_w_a2, gla_b_a)

    o_na, oc_na = _neighbourhood_attention(*lt["na"], *cx["na"], na_rpb, rows, ctx_out)

    ml_init = (jnp.zeros((B, ML_HEADS, ML_DQK, ML_DV), jnp.float32),
               jnp.zeros((B, ML_HEADS, ML_DQK), jnp.float32),
               jnp.zeros((B, ML_HEADS), jnp.float32))
    h_ml, hc_ml = _bidirectional(_mlstm_scan, lt["ml_f"], lt["ml_b"], cx["ml_f"], cx["ml_b"], ml_init)

    gla_init = jnp.zeros((B, GLA_HEADS, GLA_DK, GLA_DV), jnp.float32)
    h_gla, hc_gla = _bidirectional(_gla_scan, lt["gla_f"], lt["gla_b"], cx["gla_f"], cx["gla_b"], gla_init)

    row_cs, col_cs = _axial_rope_tables(S, DA_DQK, dt)
    q1, q2, k1, k2, v = lt["da"]
    q1, q2, k1, k2 = [_rope_2d(t, row_cs, col_cs) for t in (q1, q2, k1, k2)]
    lq1, lk1, lq2, lk2 = da_lambda.astype(jnp.float32)
    lam = jnp.exp(jnp.sum(lq1 * lk1)) - jnp.exp(jnp.sum(lq2 * lk2)) + lambda_init
    o_da, oc_da = _diff_attention(q1, q2, k1, k2, v, *cx["da"], lam, ctx_out)

    def finish(t, o_na_, h_ml_, h_gla_, o_da_):
        y_na = _merge(o_na_)
        y_ml = jax.nn.sigmoid(t["ml_o"]) * _head_norm(h_ml_, ml_norm_g, True).astype(dt)
        y_gla = jax.nn.silu(t["gla_g"]) * _head_norm(h_gla_, gla_norm_g, False).astype(dt)
        y_da = ((1.0 - lambda_init) * _head_norm(o_da_, da_norm_g, False)).astype(dt)
        return _merge_branches((y_na, y_ml, y_gla, y_da), t["gates"], w_branch, w_out)

    y = finish(lt, o_na, h_ml, h_gla, o_da)
    yc = finish(cx, oc_na, hc_ml, hc_gla, oc_da) if ctx_out else None
    return y, yc


def setup_inputs(seed: int = 0) -> dict:
    key = jax.random.key(seed)
    ks = jax.random.split(key, 21)

    def nrm(k, shape, s):
        return jax.random.normal(k, shape, jnp.float32) * s

    gate_base = jnp.concatenate([jnp.zeros((ML_HEADS,), jnp.float32), jnp.full((ML_HEADS,), ML_F_BIAS, jnp.float32),
                                 jnp.zeros((ML_HEADS,), jnp.float32), jnp.full((ML_HEADS,), ML_F_BIAS, jnp.float32)])
    return {
        "x": nrm(ks[0], (BATCH, SEQ, D_MODEL), 1.0),
        "c": nrm(ks[1], (BATCH, D_MODEL), 1.0),
        "ctx": nrm(ks[2], (BATCH, CTX_LEN, D_MODEL), 1.0),
        "c_ctx": nrm(ks[3], (D_MODEL,), 1.0),
        "w_ada": nrm(ks[4], (DEPTH, D_MODEL, N_MOD * D_MODEL), D_MODEL ** -0.5),
        "b_ada": nrm(ks[5], (DEPTH, N_MOD * D_MODEL), 0.02),
        "ln_g": 1.0 + nrm(ks[6], (DEPTH, 3, D_MODEL), 0.02),
        "ln_b": nrm(ks[7], (DEPTH, 3, D_MODEL), 0.02),
        "ffn_w_in": nrm(ks[8], (DEPTH, 2, D_MODEL, 2 * D_FF), D_MODEL ** -0.5),
        "ffn_w_out": nrm(ks[9], (DEPTH, 2, D_FF, D_MODEL), BETA * D_FF ** -0.5),
        "w_mix_in": nrm(ks[10], (DEPTH, D_MODEL, N_COLS), D_MODEL ** -0.5),
        "na_rpb": nrm(ks[11], (DEPTH, NA_HEADS, 2 * NA_KH_MAX - 1, 2 * NA_KW - 1), 0.1),
        "ml_gate_b": gate_base + nrm(ks[12], (DEPTH, 4 * ML_HEADS), 0.1),
        "ml_norm_g": 1.0 + nrm(ks[13], (DEPTH, ML_HEADS * ML_DV), 0.02),
        "gla_w_a2": nrm(ks[14], (DEPTH, 2, GLA_RANK, GLA_HEADS * GLA_DK), GLA_RANK ** -0.5),
        "gla_b_a": nrm(ks[15], (DEPTH, 2, GLA_HEADS * GLA_DK), 0.1),
        "gla_norm_g": 1.0 + nrm(ks[16], (DEPTH, GLA_HEADS * GLA_DV), 0.02),
        "da_lambda": nrm(ks[17], (DEPTH, 4, DA_DQK), 0.1),
        "da_norm_g": 1.0 + nrm(ks[18], (DEPTH, DA_HEADS * DA_DV), 0.02),
        "w_branch": nrm(ks[19], (DEPTH, N_BRANCH, BRANCH_W, D_MODEL), BRANCH_W ** -0.5),
        "w_out": nrm(ks[20], (DEPTH, D_MODEL, D_MODEL), BETA * D_MODEL ** -0.5),
    }


def reference(x, c, ctx, c_ctx, w_ada, b_ada, ln_g, ln_b, ffn_w_in, ffn_w_out, w_mix_in, na_rpb,
              ml_gate_b, ml_norm_g, gla_w_a2, gla_b_a, gla_norm_g, da_lambda, da_norm_g, w_branch, w_out):
    lat, cx = x, ctx
    for l in range(DEPTH):
        ctx_out = l < DEPTH - 1
        lambda_init = 0.8 - 0.6 * math.exp(-0.3 * l)
        mod = jnp.split((jax.nn.silu(c) @ w_ada[l] + b_ada[l])[:, None, :], N_MOD, axis=-1)
        modc = jnp.split(jax.nn.silu(c_ctx) @ w_ada[l] + b_ada[l], N_MOD, axis=-1)

        lat = _layer_norm(ALPHA * lat + FFN_HALF * mod[2] * _swiglu(_modulate(lat, mod[0], mod[1]),
                          ffn_w_in[l, 0], ffn_w_out[l, 0]), ln_g[l, 0], ln_b[l, 0])
        cx = _layer_norm(ALPHA * cx + FFN_HALF * modc[2] * _swiglu(_modulate(cx, modc[0], modc[1]),
                         ffn_w_in[l, 0], ffn_w_out[l, 0]), ln_g[l, 0], ln_b[l, 0])

        y, yc = _token_mixer(_modulate(lat, mod[3], mod[4]), _modulate(cx, modc[3], modc[4]), ctx_out,
                             w_mix_in[l], na_rpb[l], ml_gate_b[l], ml_norm_g[l], gla_w_a2[l], gla_b_a[l],
                             gla_norm_g[l], da_lambda[l], da_norm_g[l], lambda_init, w_branch[l], w_out[l])
        lat = _layer_norm(ALPHA * lat + mod[5] * y, ln_g[l, 1], ln_b[l, 1])

        lat = _layer_norm(ALPHA * lat + FFN_HALF * mod[8] * _swiglu(_modulate(lat, mod[6], mod[7]),
                          ffn_w_in[l, 1], ffn_w_out[l, 1]), ln_g[l, 2], ln_b[l, 2])
        if ctx_out:
            cx = _layer_norm(ALPHA * cx + modc[5] * yc, ln_g[l, 1], ln_b[l, 1])
            cx = _layer_norm(ALPHA * cx + FFN_HALF * modc[8] * _swiglu(_modulate(cx, modc[6], modc[7]),
                             ffn_w_in[l, 1], ffn_w_out[l, 1]), ln_g[l, 2], ln_b[l, 2])
    return lat
```

```cpp
#include <hip/hip_runtime.h>
#include <hip/hip_cooperative_groups.h>
#include <cstdio>
namespace cg = cooperative_groups;

#define LAS __attribute__((address_space(3)))
typedef unsigned short bf16;
typedef short bf16x8 __attribute__((ext_vector_type(8)));
typedef short s16x4 __attribute__((ext_vector_type(4)));
typedef float f32x4 __attribute__((ext_vector_type(4)));
typedef unsigned u32x4 __attribute__((ext_vector_type(4)));
typedef unsigned u32x2 __attribute__((ext_vector_type(2)));
#define DI __device__ __forceinline__
#define LDS_WAIT() asm volatile("s_waitcnt lgkmcnt(0)" ::: "memory")
#define MFMA16(a, b, c) __builtin_amdgcn_mfma_f32_16x16x32_bf16((a), (b), (c), 0, 0, 0)

constexpr int D = 1024, SEQ = 2048, TCTX = 256, DFF = 2816;
constexpr int RLAT = 65536, RALL = 73728;
constexpr int NP = 7680;
constexpr int C_NAQ = 0, C_NAK = 256, C_NAV = 512, C_MLQ = 768, C_MLK = 1024, C_MLV = 1280, C_MLO = 1536, C_GLQ = 1792, C_GLK = 1920, C_GLV = 2048,
              C_GLG = 2304, C_DAQ = 2560, C_DAK = 2816, C_DAV = 3072, C_MLIF = 3328, C_GLA = 3344, C_GATE = 3584;
constexpr int HROWS = 36864;
constexpr float ALPHA = 1.41421356237f;
constexpr float LOG2E = 1.44269504089f;

constexpr size_t MiB = 1u << 20;
constexpr size_t WS_MODS = 1 * MiB, WS_WIN = 4 * MiB, WS_WOUTF = 48 * MiB, WS_WMIX = 70 * MiB, WS_WB = 100 * MiB, WS_WO = 104 * MiB, WS_LATC = 108 * MiB,
                 WS_HMOD = 140 * MiB, WS_BIG = 284 * MiB, WS_HBUF = WS_BIG + 540 * MiB, WS_END = WS_HBUF + 144 * MiB;
constexpr int LDS_BYTES = 135168;

struct Params {
    const float *x, *c, *ctx, *c_ctx, *w_ada, *b_ada, *ln_g, *ln_b, *ffn_w_in, *ffn_w_out, *w_mix_in, *na_rpb, *ml_gate_b, *ml_norm_g, *gla_w_a2, *gla_b_a,
        *gla_norm_g, *da_lambda, *da_norm_g, *w_branch, *w_out;
    float* out; unsigned char* ws;
};

typedef const __attribute__((address_space(4))) Params* PP;
DI int otid() { int t = threadIdx.x; asm volatile("" : "+v"(t)); return t; }
DI int obid() { int t = blockIdx.x; asm volatile("" : "+s"(t)); return t; }
DI int ogrid() { int t = gridDim.x; asm volatile("" : "+s"(t)); return t; }
DI unsigned f2bf(float f) { unsigned u = __builtin_bit_cast(unsigned, f); return (u + 0x7fffu + ((u >> 16) & 1u)) >> 16; }
DI unsigned pk2(float lo, float hi) { return f2bf(lo) | (f2bf(hi) << 16); }
DI float bf2f(unsigned short b) { return __builtin_bit_cast(float, ((unsigned)b) << 16); }
DI float bflo(unsigned w) { return __builtin_bit_cast(float, w << 16); }
DI float bfhi(unsigned w) { return __builtin_bit_cast(float, w & 0xffff0000u); }
DI float sigm(float x) { return __builtin_amdgcn_rcpf(1.f + __expf(-x)); }
DI float logsig(float x) { return fminf(x, 0.f) - log1pf(expf(-fabsf(x))); }
DI int grow_of(int pm, int half) { return half < 0 ? pm * 256 : (pm < 128 ? half * 32768 + pm * 256 : RLAT + half * 4096 + (pm - 128) * 256); }
DI float* latrow(PP p, int r) { return r < RLAT ? p->out + (size_t)r * D : (float*)(p->ws + WS_LATC) + (size_t)(r - RLAT) * D; }
DI const float* xrow(PP p, int r) { return r < RLAT ? p->x + (size_t)r * D : p->ctx + (size_t)(r - RLAT) * D; }
DI const float* modrow(PP p, int l, int r) { return (const float*)(p->ws + WS_MODS) + (size_t)(l * 33 + (r < RLAT ? (r >> 11) : 32)) * 9216; }

namespace pg8 {
constexpr int BM = 256, BK = 64, HALF = 128, HTB = HALF * BK * 2, NXCD = 8, WGM = 8;
DI int lds_byte(int r, int c) { const int st = (r >> 4) * 2 + (c >> 5), rr = r & 15, cc = c & 31, ob = rr * 64 + cc * 2; return st * 1024 + (ob ^ (((ob >> 9) & 1) << 5)); }
DI void stage_rc(int b, int& R, int& C) { const int st = b / 1024, sb = b % 1024, swz = sb ^ (((sb >> 9) & 1) << 5); R = (st >> 1) * 16 + swz / 64; C = (st & 1) * 32 + (swz % 64) / 2; }
DI int perm32(int rho) { const int n = rho >> 4, i = rho & 15; return 8 * (i >> 2) + 4 * n + (i & 3); }
struct Unit { int pm, pn, j; };
struct Order {
    int nM, nN, nwg, G, c;
    DI void init(int nM_, int nN_) { nM = nM_; nN = nN_; nwg = nM * nN; G = ogrid(); c = obid(); }
    DI bool tile(long L, Unit& u) const {
        if (L >= nwg) return false;
        int wgid = (int)L; { const int q = nwg / NXCD, r = nwg % NXCD, xcd = wgid % NXCD, off = wgid / NXCD; wgid = (xcd < r ? xcd * (q + 1) : r * (q + 1) + (xcd - r) * q) + off; }
        const int nig = WGM * nN, gid = wgid / nig, fm = gid * WGM, gsz = (nM - fm) < WGM ? (nM - fm) : WGM;
        u.pm = fm + ((wgid % nig) % gsz); u.pn = (wgid % nig) / gsz; u.j = 0; return true;
    }
};
typedef f32x4 Acc[2][2][4][2];

template <class P>
DI void gemm_phase(LAS unsigned char* lds, const P& p) {
    const int tid = otid(), wid = __builtin_amdgcn_readfirstlane(tid >> 6), lane = tid & 63, wr = wid >> 2, wc = wid & 3, fr = lane & 15, fq = lane >> 4;
    const int K = p.K, nt = K / BK; const int lda = p.lda;
    unsigned voffA[2], voffB[2];
#pragma unroll
    for (int i = 0; i < 2; ++i) { int R, C; stage_rc(tid * 16 + i * 8192, R, C); const int Rb = P::PERM ? ((R & ~31) + perm32(R & 31)) : R;
        voffA[i] = (unsigned)(R * lda + C) * 2u; voffB[i] = (unsigned)(Rb * K + C) * 2u; }
    const size_t kstep = (size_t)(BK * 2);
    const size_t hstepA = (size_t)HALF * lda * 2, hstepB = (size_t)HALF * K * 2;
    const unsigned ldsw = (unsigned)wid * 1024u;
    const int aoff = lds_byte(wr * 64 + fr, fq * 8), boff = lds_byte(wc * 32 + fr, fq * 8);
#define PG8_SA(b, h) (((b) * 2 + (h)) * HTB)
#define PG8_SB(b, h) ((4 + (b) * 2 + (h)) * HTB)
#define PG8_STAGE(bufoff, gbase, voff) do { _Pragma("unroll") for (int _i = 0; _i < 2; ++_i) \
        __builtin_amdgcn_global_load_lds((const unsigned*)((const char*)(gbase) + (voff)[_i]), (LAS unsigned*)(lds + (bufoff) + ldsw + _i * 8192), 16, 0, 0); } while (0)
#define PG8_LDA(dst, b, h) do { _Pragma("unroll") for (int m = 0; m < 4; ++m) _Pragma("unroll") for (int k = 0; k < 2; ++k) dst[m][k] = *(const LAS bf16x8*)(lds + PG8_SA(b, h) + aoff + m * 2048 + k * 1024); } while (0)
#define PG8_LDB(dst, b, h) do { _Pragma("unroll") for (int n = 0; n < 2; ++n) _Pragma("unroll") for (int k = 0; k < 2; ++k) dst[n][k] = *(const LAS bf16x8*)(lds + PG8_SB(b, h) + boff + n * 2048 + k * 1024); } while (0)
#define PG8_MMA(ai, bj, At, Bt) do { __builtin_amdgcn_s_setprio(1); _Pragma("unroll") for (int m = 0; m < 4; ++m) _Pragma("unroll") for (int n = 0; n < 2; ++n) _Pragma("unroll") for (int k = 0; k < 2; ++k) \
        acc[ai][bj][m][n] = __builtin_amdgcn_mfma_f32_16x16x32_bf16(Bt[n][k], At[m][k], acc[ai][bj][m][n], 0, 0, 0); __builtin_amdgcn_s_setprio(0); } while (0)
#define PG8_WAIT_V(n) asm volatile("s_waitcnt vmcnt(" #n ")" ::: "memory")
#define PG8_WAIT_L(n) asm volatile("s_waitcnt lgkmcnt(" #n ")" ::: "memory")
#define PG8_BAR __builtin_amdgcn_s_barrier()
#define PG8_SCHED __builtin_amdgcn_sched_barrier(0)
    Unit cur, nxt; int ui = 0;
    if (!p.next(0, cur)) return;
    Acc acc;
#pragma unroll
    for (int a = 0; a < 2; ++a)
#pragma unroll
        for (int b = 0; b < 2; ++b)
#pragma unroll
            for (int m = 0; m < 4; ++m)
#pragma unroll
                for (int n = 0; n < 2; ++n) acc[a][b][m][n] = (f32x4){0.f, 0.f, 0.f, 0.f};
    bf16x8 At[4][2], B0[2][2], B1[2][2];
    const char* cA = p.abase(cur); const char* cB = p.bbase(cur);
    PG8_STAGE(PG8_SB(0, 0), cB, voffB); PG8_STAGE(PG8_SA(0, 0), cA, voffA); PG8_STAGE(PG8_SB(0, 1), cB + hstepB, voffB); PG8_STAGE(PG8_SA(0, 1), cA + hstepA, voffA);
    if (wr == 1) PG8_BAR;
    PG8_WAIT_V(4); PG8_BAR;
    PG8_STAGE(PG8_SB(1, 0), cB + kstep, voffB); PG8_STAGE(PG8_SA(1, 0), cA + kstep, voffA); PG8_STAGE(PG8_SB(1, 1), cB + hstepB + kstep, voffB);
    PG8_WAIT_V(6); PG8_BAR;
    for (;;) {
        const bool has_next = p.next(ui + 1, nxt);
        const char* nA = has_next ? p.abase(nxt) : cA; const char* nB = has_next ? p.bbase(nxt) : cB;
        for (int t = 0; t < nt; t += 2) {
            const bool last = (t == nt - 2);
            const char* a1 = cA + (size_t)(t + 1) * kstep;
            const char* a2 = last ? nA : cA + (size_t)(t + 2) * kstep; const char* b2 = last ? nB : cB + (size_t)(t + 2) * kstep;
            const char* a3 = a2 + kstep; const char* b3 = b2 + kstep;
            PG8_LDB(B0, 0, 0); PG8_SCHED; PG8_LDA(At, 0, 0); PG8_STAGE(PG8_SA(1, 1), a1 + hstepA, voffA);
            PG8_WAIT_L(8); PG8_BAR; PG8_WAIT_L(0); PG8_MMA(0, 0, At, B0); PG8_BAR; PG8_SCHED;
            PG8_LDB(B1, 0, 1); PG8_STAGE(PG8_SB(0, 0), b2, voffB);
            PG8_BAR; PG8_WAIT_L(0); PG8_MMA(0, 1, At, B1); PG8_BAR;
            PG8_LDA(At, 0, 1); PG8_STAGE(PG8_SA(0, 0), a2, voffA);
            PG8_BAR; PG8_WAIT_L(0); PG8_MMA(1, 0, At, B0); PG8_BAR; PG8_SCHED;
            PG8_STAGE(PG8_SB(0, 1), b2 + hstepB, voffB);
            PG8_WAIT_V(6); PG8_BAR; PG8_MMA(1, 1, At, B1); PG8_BAR;
            PG8_LDB(B0, 1, 0); PG8_SCHED; PG8_LDA(At, 1, 0); PG8_STAGE(PG8_SA(0, 1), a2 + hstepA, voffA);
            PG8_WAIT_L(8); PG8_BAR; PG8_WAIT_L(0); PG8_MMA(0, 0, At, B0); PG8_BAR; PG8_SCHED;
            PG8_LDB(B1, 1, 1); PG8_STAGE(PG8_SB(1, 0), b3, voffB);
            PG8_BAR; PG8_WAIT_L(0); PG8_MMA(0, 1, At, B1); PG8_BAR;
            PG8_LDA(At, 1, 1); PG8_STAGE(PG8_SA(1, 0), a3, voffA);
            PG8_BAR; PG8_WAIT_L(0); PG8_MMA(1, 0, At, B0); PG8_BAR; PG8_SCHED;
            PG8_STAGE(PG8_SB(1, 1), b3 + hstepB, voffB);
            PG8_WAIT_V(6); PG8_BAR; PG8_MMA(1, 1, At, B1); PG8_BAR;
        }
        p.epi(acc, cur, wr, wc, fr, fq);
        if (!has_next) break;
        if (!P::KEEP) {
#pragma unroll
            for (int a = 0; a < 2; ++a)
#pragma unroll
                for (int b = 0; b < 2; ++b)
#pragma unroll
                    for (int m = 0; m < 4; ++m)
#pragma unroll
                        for (int n = 0; n < 2; ++n) acc[a][b][m][n] = (f32x4){0.f, 0.f, 0.f, 0.f};
        }
        cur = nxt; cA = nA; cB = nB; ++ui;
    }
    PG8_WAIT_V(0);
    if (wr == 0) PG8_BAR;
    PG8_BAR;
#undef PG8_SA
#undef PG8_SB
#undef PG8_STAGE
#undef PG8_LDA
#undef PG8_LDB
#undef PG8_MMA
#undef PG8_WAIT_V
#undef PG8_WAIT_L
#undef PG8_BAR
#undef PG8_SCHED
}

struct ProbFfnIn {
    static constexpr bool PERM = true, KEEP = false;
    int K, lda; Order o; const bf16* A; const bf16* Bt; bf16* act;
    DI bool next(int i, Unit& u) const { return o.tile((long)i * o.G + o.c, u); }
    DI const char* abase(const Unit& u) const { return (const char*)(A + (size_t)u.pm * 256 * lda); }
    DI const char* bbase(const Unit& u) const { return (const char*)(Bt + (size_t)u.pn * 256 * K); }
    DI void epi(Acc& acc, const Unit& u, int wr, int wc, int fr, int fq) const {
#pragma unroll
        for (int ai = 0; ai < 2; ++ai)
#pragma unroll
            for (int m = 0; m < 4; ++m) {
                const int row = u.pm * 256 + ai * 128 + wr * 64 + m * 16 + fr;
                float o8[8];
#pragma unroll
                for (int n = 0; n < 2; ++n)
#pragma unroll
                    for (int e = 0; e < 4; ++e) { const float a = acc[ai][0][m][n][e], b = acc[ai][1][m][n][e]; o8[n * 4 + e] = a * sigm(a) * b; }
                u32x4 w; w.x = pk2(o8[0], o8[1]); w.y = pk2(o8[2], o8[3]); w.z = pk2(o8[4], o8[5]); w.w = pk2(o8[6], o8[7]);
                *(u32x4*)(act + (size_t)row * DFF + u.pn * 128 + wc * 32 + 8 * fq) = w;
            }
    }
};
struct ProbRes {
    static constexpr bool PERM = false, KEEP = false;
    int K, lda; Order o; const bf16* A; const bf16* Bt; PP prm; int layer, gidx, first; float coef;
    DI bool next(int i, Unit& u) const { return o.tile((long)i * o.G + o.c, u); }
    DI const char* abase(const Unit& u) const { return (const char*)(A + (size_t)u.pm * 256 * lda); }
    DI const char* bbase(const Unit& u) const { return (const char*)(Bt + (size_t)u.pn * 256 * K); }
    DI void epi(Acc& acc, const Unit& u, int wr, int wc, int fr, int fq) const {
        const int r0 = u.pm * 256;
        const float* gate = modrow(prm, layer, r0) + gidx * D;
        float* lat = latrow(prm, r0); const float* res = first ? xrow(prm, r0) : lat;
        const int col0 = u.pn * 256 + wc * 32 + 4 * fq;
#pragma unroll
        for (int bj = 0; bj < 2; ++bj)
#pragma unroll
            for (int n = 0; n < 2; ++n) {
                const int c = col0 + bj * 128 + n * 16;
                const f32x4 g4 = *(const f32x4*)(gate + c) * coef;
#pragma unroll
                for (int ai = 0; ai < 2; ++ai)
#pragma unroll
                    for (int m = 0; m < 4; ++m) {
                        const size_t off = (size_t)(ai * 128 + wr * 64 + m * 16 + fr) * D + c;
                        const f32x4 rv = *(const f32x4*)(res + off);
                        *(f32x4*)(lat + off) = rv * ALPHA + g4 * acc[ai][bj][m][n];
                    }
            }
    }
};
struct ProbMix {
    static constexpr bool PERM = true, KEEP = false;
    int K, lda; Order o; const bf16* A; const bf16* Bt; bf16* Pb; int half;
    DI bool next(int i, Unit& u) const { return o.tile((long)i * o.G + o.c, u); }
    DI const char* abase(const Unit& u) const { return (const char*)(A + (size_t)grow_of(u.pm, half) * lda); }
    DI const char* bbase(const Unit& u) const { return (const char*)(Bt + (size_t)u.pn * 256 * K); }
    DI void epi(Acc& acc, const Unit& u, int wr, int wc, int fr, int fq) const {
        const bool sg = u.pn >= 14;
#pragma unroll
        for (int ai = 0; ai < 2; ++ai)
#pragma unroll
            for (int m = 0; m < 4; ++m) {
                const int row = u.pm * 256 + ai * 128 + wr * 64 + m * 16 + fr;
#pragma unroll
                for (int bj = 0; bj < 2; ++bj) {
                    f32x4 v0 = acc[ai][bj][m][0], v1 = acc[ai][bj][m][1];
                    if (sg) {
#pragma unroll
                        for (int e = 0; e < 4; ++e) { v0[e] = sigm(v0[e]); v1[e] = sigm(v1[e]); }
                    }
                    u32x4 w; w.x = pk2(v0[0], v0[1]); w.y = pk2(v0[2], v0[3]); w.z = pk2(v1[0], v1[1]); w.w = pk2(v1[2], v1[3]);
                    *(u32x4*)(Pb + (size_t)row * NP + u.pn * 256 + bj * 128 + wc * 32 + 8 * fq) = w;
                }
            }
    }
};
struct ProbMerge {
    static constexpr bool PERM = true, KEEP = true;
    int K, lda; Order o; const bf16* Pb; const bf16* Wb; bf16* merged; int half;
    DI bool next(int i, Unit& u) const { const bool ok = o.tile((long)(i >> 2) * o.G + o.c, u); u.j = i & 3; return ok; }
    DI int acol(int j) const { return j == 0 ? C_NAQ : (j == 1 ? C_MLO : (j == 2 ? C_GLG : C_DAQ)); }
    DI const char* abase(const Unit& u) const { return (const char*)(Pb + (size_t)u.pm * 256 * lda + acol(u.j)); }
    DI const char* bbase(const Unit& u) const { return (const char*)(Wb + (size_t)u.j * 1024 * 256 + (size_t)u.pn * 256 * K); }
    DI void epi(Acc& acc, const Unit& u, int wr, int wc, int fr, int fq) const {
        const int j = u.j; const int grow0 = grow_of(u.pm, half);
#pragma unroll
        for (int ai = 0; ai < 2; ++ai)
#pragma unroll
            for (int m = 0; m < 4; ++m) {
                const int rl = ai * 128 + wr * 64 + m * 16 + fr;
#pragma unroll
                for (int bj = 0; bj < 2; ++bj) {
                    const int c = u.pn * 256 + bj * 128 + wc * 32 + 8 * fq;
                    const bf16* gp = Pb + (size_t)(u.pm * 256 + rl) * NP + C_GATE + c;
                    const u32x4 ga = *(const u32x4*)(gp + j * 1024);
                    float s[8] = {bflo(ga.x), bfhi(ga.x), bflo(ga.y), bfhi(ga.y), bflo(ga.z), bfhi(ga.z), bflo(ga.w), bfhi(ga.w)};
                    if (j < 3) {
                        const u32x4 gb = *(const u32x4*)(gp + (j + 1) * 1024);
                        float t[8] = {bflo(gb.x), bfhi(gb.x), bflo(gb.y), bfhi(gb.y), bflo(gb.z), bfhi(gb.z), bflo(gb.w), bfhi(gb.w)};
#pragma unroll
                        for (int n = 0; n < 2; ++n)
#pragma unroll
                            for (int e = 0; e < 4; ++e) acc[ai][bj][m][n][e] = acc[ai][bj][m][n][e] * s[n * 4 + e] / fmaxf(t[n * 4 + e], 1e-30f);
                    } else {
                        float o8[8];
#pragma unroll
                        for (int n = 0; n < 2; ++n)
#pragma unroll
                            for (int e = 0; e < 4; ++e) { o8[n * 4 + e] = acc[ai][bj][m][n][e] * s[n * 4 + e]; acc[ai][bj][m][n][e] = 0.f; }
                        u32x4 w; w.x = pk2(o8[0], o8[1]); w.y = pk2(o8[2], o8[3]); w.z = pk2(o8[4], o8[5]); w.w = pk2(o8[6], o8[7]);
                        *(u32x4*)(merged + (size_t)(grow0 + rl) * D + c) = w;
                    }
                }
            }
    }
};
}

DI int map_ident(int n) { return n; }
DI int map_ffn(int n) { const int t = n >> 8, w = n & 255; return (w >> 7) * DFF + t * 128 + (w & 127); }
DI int map_mix(int n) {
    if (n < 1792) return n;
    if (n < 2560) return n + 16;
    if (n < 3328) return n + 48;
    if (n < 3344) return 1792 + (n - 3328);
    if (n < 3376) return 2576 + (n - 3344);
    if (n < 3584) return -1;
    return 3376 + (n - 3584);
}
template <int MAP>
DI void transpose_item(const float* W, int K, int Nsrc, bf16* WT, LAS float* scr, int kb, int nb, int lane) {
    const int k0 = 64 * kb, n0 = 32 * nb;
    const int nn = n0 + (lane & 31);
    const int sc = MAP == 0 ? map_ident(nn) : (MAP == 1 ? map_ffn(nn) : map_mix(nn));
#pragma unroll 8
    for (int i = 0; i < 32; ++i) { const int kk = 2 * i + (lane >> 5); scr[kk * 33 + (lane & 31)] = sc >= 0 ? W[(size_t)(k0 + kk) * Nsrc + sc] : 0.f; }
    LDS_WAIT();
    const int c = lane & 7;
#pragma unroll
    for (int j = 0; j < 4; ++j) { const int n = (lane >> 3) + 8 * j; const LAS float* s = scr + (8 * c) * 33 + n;
        u32x4 o; o.x = pk2(s[0 * 33], s[1 * 33]); o.y = pk2(s[2 * 33], s[3 * 33]); o.z = pk2(s[4 * 33], s[5 * 33]); o.w = pk2(s[6 * 33], s[7 * 33]);
        *(u32x4*)(WT + (size_t)(n0 + n) * K + k0 + 8 * c) = o; }
    LDS_WAIT();
}

DI void mods_item(PP p, LAS float* lds, int item) {
    const int l = item / 72, cbk = item % 72;
    const int tid = otid(), col = tid & 127, g = tid >> 7;
    LAS float* sc = lds; LAS float* red = lds + 33 * 128;
    float acc[33];
#pragma unroll
    for (int r = 0; r < 33; ++r) acc[r] = 0.f;
    const float* W = p->w_ada + (size_t)l * 1024 * 9216 + 128 * cbk + col;
    for (int kc = 0; kc < 8; ++kc) {
        __syncthreads();
        for (int e = tid; e < 33 * 128; e += 512) { const int r = e >> 7, kk = e & 127; const float v = r < 32 ? p->c[r * 1024 + kc * 128 + kk] : p->c_ctx[kc * 128 + kk]; sc[e] = v / (1.f + expf(-v)); }
        __syncthreads();
        for (int kk = 0; kk < 32; ++kk) { const int k = g * 32 + kk; const float w = W[(size_t)(kc * 128 + k) * 9216];
#pragma unroll
            for (int r = 0; r < 33; ++r) acc[r] += sc[r * 128 + k] * w; }
    }
#pragma unroll
    for (int r = 0; r < 33; ++r) red[(g * 33 + r) * 128 + col] = acc[r];
    __syncthreads();
    float* mods = (float*)(p->ws + WS_MODS);
    for (int e = tid; e < 33 * 128; e += 512) { const int r = e >> 7, cc = e & 127;
        const float v = red[(0 * 33 + r) * 128 + cc] + red[(1 * 33 + r) * 128 + cc] + red[(2 * 33 + r) * 128 + cc] + red[(3 * 33 + r) * 128 + cc];
        mods[(size_t)(l * 33 + r) * 9216 + 128 * cbk + cc] = v + p->b_ada[l * 9216 + 128 * cbk + cc]; }
    __syncthreads();
}

DI void p0_prologue(PP p, LAS unsigned char* lds) {
    for (int it = obid(); it < 144; it += ogrid()) mods_item(p, (LAS float*)lds, it);
    __syncthreads();
    const int wave = otid() >> 6, lane = otid() & 63;
    LAS float* scr = (LAS float*)(lds + wave * 8704);
    const int gw = obid() * 8 + wave, NGW = ogrid() * 8;
    constexpr int I_IN = 16 * 176, I_OUT = 44 * 32, I_MIX = 16 * 240, I_B = 4 * 32, I_O = 16 * 32;
    constexpr int NITEMS = 4 * I_IN + 4 * I_OUT + 2 * I_MIX + 8 * I_B + 2 * I_O;
    for (int it = gw; it < NITEMS; it += NGW) {
        int r = it;
        if (r < 4 * I_IN) { const int w = r / I_IN, q = r % I_IN; transpose_item<1>(p->ffn_w_in + (size_t)w * 1024 * 5632, 1024, 5632, (bf16*)(p->ws + WS_WIN) + (size_t)w * 5632 * 1024, scr, q / 176, q % 176, lane); continue; } r -= 4 * I_IN;
        if (r < 4 * I_OUT) { const int w = r / I_OUT, q = r % I_OUT; transpose_item<0>(p->ffn_w_out + (size_t)w * DFF * 1024, DFF, 1024, (bf16*)(p->ws + WS_WOUTF) + (size_t)w * 1024 * DFF, scr, q / 32, q % 32, lane); continue; } r -= 4 * I_OUT;
        if (r < 2 * I_MIX) { const int w = r / I_MIX, q = r % I_MIX; transpose_item<2>(p->w_mix_in + (size_t)w * 1024 * 7472, 1024, 7472, (bf16*)(p->ws + WS_WMIX) + (size_t)w * NP * 1024, scr, q / 240, q % 240, lane); continue; } r -= 2 * I_MIX;
        if (r < 8 * I_B) { const int w = r / I_B, q = r % I_B; transpose_item<0>(p->w_branch + (size_t)w * 256 * 1024, 256, 1024, (bf16*)(p->ws + WS_WB) + (size_t)w * 1024 * 256, scr, q / 32, q % 32, lane); continue; } r -= 8 * I_B;
        { const int w = r / I_O, q = r % I_O; transpose_item<0>(p->w_out + (size_t)w * 1024 * 1024, 1024, 1024, (bf16*)(p->ws + WS_WO) + (size_t)w * 1024 * 1024, scr, q / 32, q % 32, lane); }
    }
}

DI float wave_sum(float v) {
#pragma unroll
    for (int o = 1; o < 64; o <<= 1) v += __shfl_xor(v, o);
    return v;
}
DI void rows_phase(PP p, int mode, int nrows, int lnl, int lnw, bool hm, int ml, int ishift, int iscale) {
    const int wave = otid() >> 6, lane = otid() & 63;
    const int gw = obid() * 8 + wave, NGW = ogrid() * 8;
    bf16* hmod = (bf16*)(p->ws + WS_HMOD);
    for (int r = gw; r < nrows; r += NGW) {
        f32x4 v[4];
        if (mode == 0) { const f32x4* xr = (const f32x4*)xrow(p, r) + lane;
#pragma unroll
            for (int j = 0; j < 4; ++j) v[j] = xr[64 * j];
        } else {
            f32x4* lr = (f32x4*)latrow(p, r) + lane; float s = 0.f;
#pragma unroll
            for (int j = 0; j < 4; ++j) { v[j] = lr[64 * j]; s += (v[j].x + v[j].y) + (v[j].z + v[j].w); }
            const float mean = wave_sum(s) * (1.f / D); float s2 = 0.f;
#pragma unroll
            for (int j = 0; j < 4; ++j) { v[j] = v[j] - mean; s2 += (v[j].x * v[j].x + v[j].y * v[j].y) + (v[j].z * v[j].z + v[j].w * v[j].w); }
            const float rstd = 1.f / sqrtf(wave_sum(s2) * (1.f / D) + 1e-5f);
            const f32x4* gg = (const f32x4*)(p->ln_g + (size_t)(lnl * 3 + lnw) * D) + lane; const f32x4* bb = (const f32x4*)(p->ln_b + (size_t)(lnl * 3 + lnw) * D) + lane;
#pragma unroll
            for (int j = 0; j < 4; ++j) { v[j] = v[j] * rstd * gg[64 * j] + bb[64 * j]; lr[64 * j] = v[j]; }
        }
        if (hm) {
            const float* mr = modrow(p, ml, r);
            const f32x4* sh = (const f32x4*)(mr + ishift * D) + lane; const f32x4* sc = (const f32x4*)(mr + iscale * D) + lane;
            u32x2* o8 = (u32x2*)(hmod + (size_t)r * D) + lane;
#pragma unroll
            for (int j = 0; j < 4; ++j) { const f32x4 h = v[j] * (sc[64 * j] + 1.f) + sh[64 * j]; u32x2 w; w.x = pk2(h.x, h.y); w.y = pk2(h.z, h.w); o8[64 * j] = w; }
        }
    }
}

DI bf16x8 ld8(const bf16* p) { return *(const bf16x8*)p; }
DI bf16x8 cat4(s16x4 a, s16x4 b) { return __builtin_shufflevector(a, b, 0, 1, 2, 3, 4, 5, 6, 7); }
DI f32x4 mm16(const LAS bf16* A, int lda, int m0, const LAS bf16* B, int ldb, int n0, int K, f32x4 acc, int ql, int g) {
    for (int k0 = 0; k0 < K; k0 += 32) {
        const bf16x8 a = *(const LAS bf16x8*)(A + (m0 + ql) * lda + k0 + 8 * g);
        const bf16x8 b = *(const LAS bf16x8*)(B + (n0 + ql) * ldb + k0 + 8 * g);
        acc = MFMA16(a, b, acc);
    }
    return acc;
}

DI void da_item(PP p, bf16* Pb, LAS unsigned char* lds, int l, bool ctxq, int bl, int h, int qb, float lam, float lam_init) {
    LAS bf16* K1s = (LAS bf16*)lds; LAS bf16* K2s = (LAS bf16*)(lds + 5120); LAS bf16* Vt = (LAS bf16*)(lds + 10240); LAS float* tab = (LAS float*)(lds + 20480);
    const int tid = otid(), wave = tid >> 6, lane = tid & 63, g = lane >> 4, ql = lane & 15;
    const int latbase = bl * 2048, ctxbase = 32768 + bl * 256;
    __syncthreads();
    { const int pos = tid >> 3, i = tid & 7; const float inv = exp2f(-(float)i * (13.287712379549449f / 8.f)); float s, c; sincosf((float)pos * inv, &s, &c); tab[tid * 2] = c; tab[tid * 2 + 1] = s; }
    __syncthreads();
    const float qscale = 0.17677669529663687f * LOG2E;
    bf16x8 qf[2][2];
#pragma unroll
    for (int mp = 0; mp < 2; ++mp)
#pragma unroll
        for (int qg = 0; qg < 2; ++qg) {
            const int tq = (ctxq ? 0 : qb * 256) + wave * 32 + qg * 16 + ql;
            const bf16* qp = Pb + (size_t)((ctxq ? ctxbase : latbase) + tq) * NP + C_DAQ + 64 * h + 32 * mp;
            const bf16x8 own = ld8(qp + 8 * g), oth = ld8(qp + 8 * (g ^ 1));
            float o[8];
            if (ctxq) {
#pragma unroll
                for (int e = 0; e < 8; ++e) o[e] = bf2f((unsigned short)own[e]);
            } else {
                const int pos = (g < 2) ? (tq >> 6) : (tq & 63);
#pragma unroll
                for (int e = 0; e < 8; ++e) { const float c = tab[(pos * 8 + e) * 2], s = tab[(pos * 8 + e) * 2 + 1]; const float a = bf2f((unsigned short)own[e]), b = bf2f((unsigned short)oth[e]);
                    o[e] = (g & 1) ? (b * s + a * c) : (a * c - b * s); }
            }
            u32x4 w; w.x = pk2(o[0] * qscale, o[1] * qscale); w.y = pk2(o[2] * qscale, o[3] * qscale); w.z = pk2(o[4] * qscale, o[5] * qscale); w.w = pk2(o[6] * qscale, o[7] * qscale);
            qf[mp][qg] = __builtin_bit_cast(bf16x8, w);
        }
    f32x4 O[2][2][4]; float mrun[2][2], lsum[2][2];
#pragma unroll
    for (int a = 0; a < 2; ++a)
#pragma unroll
        for (int b = 0; b < 2; ++b) { mrun[a][b] = -INFINITY; lsum[a][b] = 0.f;
#pragma unroll
            for (int k = 0; k < 4; ++k) O[a][b][k] = (f32x4){0.f, 0.f, 0.f, 0.f}; }
    const int ntiles = ctxq ? 4 : 36;
    for (int kt = 0; kt < ntiles; ++kt) {
        const bool lat_k = !ctxq && kt < 32;
        const int krow0 = lat_k ? latbase + kt * 64 : ctxbase + (ctxq ? kt : kt - 32) * 64;
        __syncthreads();
        if (tid < 256) {
            const int key = tid >> 2, mp = (tid >> 1) & 1, sec = tid & 1;
            const bf16* kp = Pb + (size_t)(krow0 + key) * NP + C_DAK + 64 * h + 32 * mp + 16 * sec;
            const bf16x8 y1 = ld8(kp), y2 = ld8(kp + 8);
            LAS bf16* dst = (mp ? K2s : K1s) + key * 40 + 16 * sec;
            if (lat_k) {
                const int tk = kt * 64 + key; const int pos = sec == 0 ? (tk >> 6) : (tk & 63);
                float o1[8], o2[8];
#pragma unroll
                for (int e = 0; e < 8; ++e) { const float c = tab[(pos * 8 + e) * 2], s = tab[(pos * 8 + e) * 2 + 1]; const float a = bf2f((unsigned short)y1[e]), b = bf2f((unsigned short)y2[e]); o1[e] = a * c - b * s; o2[e] = a * s + b * c; }
                u32x4 w1, w2; w1.x = pk2(o1[0], o1[1]); w1.y = pk2(o1[2], o1[3]); w1.z = pk2(o1[4], o1[5]); w1.w = pk2(o1[6], o1[7]);
                w2.x = pk2(o2[0], o2[1]); w2.y = pk2(o2[2], o2[3]); w2.z = pk2(o2[4], o2[5]); w2.w = pk2(o2[6], o2[7]);
                *(LAS u32x4*)dst = w1; *(LAS u32x4*)(dst + 8) = w2;
            } else { *(LAS bf16x8*)dst = y1; *(LAS bf16x8*)(dst + 8) = y2; }
        } else {
            const int idx = tid - 256;
#pragma unroll
            for (int i = 0; i < 2; ++i) { const int piece = idx + 256 * i, key = piece >> 3, seg = piece & 7;
                const bf16x8 v = ld8(Pb + (size_t)(krow0 + key) * NP + C_DAV + 64 * h + 8 * seg);
#pragma unroll
                for (int e = 0; e < 8; ++e) Vt[(8 * seg + e) * 72 + key] = (bf16)v[e]; }
        }
        __syncthreads();
#pragma unroll
        for (int st = 0; st < 2; ++st) {
            bf16x8 vf[4];
#pragma unroll
            for (int blk = 0; blk < 4; ++blk) { const LAS bf16* vp = Vt + (16 * blk + ql) * 72 + 32 * st + 4 * g; vf[blk] = cat4(*(const LAS s16x4*)vp, *(const LAS s16x4*)(vp + 16)); }
#pragma unroll
            for (int mp = 0; mp < 2; ++mp) {
                const LAS bf16* Ks = mp ? K2s : K1s;
                const bf16x8 ka = *(const LAS bf16x8*)(Ks + (32 * st + ql) * 40 + 8 * g), kb = *(const LAS bf16x8*)(Ks + (32 * st + 16 + ql) * 40 + 8 * g);
#pragma unroll
                for (int qg = 0; qg < 2; ++qg) {
                    const f32x4 z = {0.f, 0.f, 0.f, 0.f};
                    f32x4 s0 = MFMA16(ka, qf[mp][qg], z), s1 = MFMA16(kb, qf[mp][qg], z);
                    float mx = fmaxf(fmaxf(fmaxf(s0[0], s0[1]), fmaxf(s0[2], s0[3])), fmaxf(fmaxf(s1[0], s1[1]), fmaxf(s1[2], s1[3])));
                    mx = fmaxf(mx, __shfl_xor(mx, 16)); mx = fmaxf(mx, __shfl_xor(mx, 32));
                    const float mnew = fmaxf(mrun[mp][qg], mx), alpha = exp2f(mrun[mp][qg] - mnew); mrun[mp][qg] = mnew;
                    float pv[8]; float ps = 0.f;
#pragma unroll
                    for (int e = 0; e < 4; ++e) { pv[e] = exp2f(s0[e] - mnew); pv[4 + e] = exp2f(s1[e] - mnew); ps += pv[e] + pv[4 + e]; }
                    lsum[mp][qg] = lsum[mp][qg] * alpha + ps;
                    u32x4 w; w.x = pk2(pv[0], pv[1]); w.y = pk2(pv[2], pv[3]); w.z = pk2(pv[4], pv[5]); w.w = pk2(pv[6], pv[7]);
                    const bf16x8 pt = __builtin_bit_cast(bf16x8, w);
#pragma unroll
                    for (int blk = 0; blk < 4; ++blk) { O[mp][qg][blk] = O[mp][qg][blk] * alpha; O[mp][qg][blk] = MFMA16(vf[blk], pt, O[mp][qg][blk]); }
                }
            }
        }
    }
    const float* ng = p->da_norm_g + l * 256 + 64 * h;
#pragma unroll
    for (int qg = 0; qg < 2; ++qg) {
        float l1 = lsum[0][qg]; l1 += __shfl_xor(l1, 16); l1 += __shfl_xor(l1, 32);
        float l2 = lsum[1][qg]; l2 += __shfl_xor(l2, 16); l2 += __shfl_xor(l2, 32);
        const float i1 = 1.f / l1, i2 = lam / l2;
        f32x4 o[4]; float ss = 0.f;
#pragma unroll
        for (int blk = 0; blk < 4; ++blk) { o[blk] = O[0][qg][blk] * i1 - O[1][qg][blk] * i2; ss += o[blk][0] * o[blk][0] + o[blk][1] * o[blk][1] + o[blk][2] * o[blk][2] + o[blk][3] * o[blk][3]; }
        ss += __shfl_xor(ss, 16); ss += __shfl_xor(ss, 32);
        const float rn = (1.f - lam_init) / sqrtf(ss * (1.f / 64.f) + 1e-6f);
        const int tq = (ctxq ? 0 : qb * 256) + wave * 32 + qg * 16 + ql;
        bf16* op = Pb + (size_t)((ctxq ? ctxbase : latbase) + tq) * NP + C_DAQ + 64 * h;
#pragma unroll
        for (int blk = 0; blk < 4; ++blk) { const f32x4 gg = *(const f32x4*)(ng + 16 * blk + 4 * g); const f32x4 y = o[blk] * rn * gg; u32x2 w; w.x = pk2(y[0], y[1]); w.y = pk2(y[2], y[3]); *(u32x2*)(op + 16 * blk + 4 * g) = w; }
    }
}

DI void na_wave(PP p, bf16* Pb, const LAS float* bias, LAS bf16* Vt, bool ctxq, int bl, int h, int r, int cb, int cq0) {
    const int lane = otid() & 63, g = lane >> 4, ql = lane & 15;
    const int latbase = bl * 2048, ctxbase = 32768 + bl * 256;
    const int cq = 16 * cb + ql;
    const int rowq = ctxq ? ctxbase + cq0 + ql : latbase + 64 * r + cq;
    const int r0 = min(max(r - 4, 0), 24), cs = cb == 0 ? 0 : (cb == 1 ? 8 : (cb == 2 ? 24 : 32)), c0 = min(max(cq - 8, 0), 48);
    bf16x8 qf[2];
    qf[0] = ld8(Pb + (size_t)rowq * NP + C_NAQ + 64 * h + 8 * g); qf[1] = ld8(Pb + (size_t)rowq * NP + C_NAQ + 64 * h + 32 + 8 * g);
    f32x4 O[4]; float mrun = -INFINITY, lsum = 0.f;
#pragma unroll
    for (int k = 0; k < 4; ++k) O[k] = (f32x4){0.f, 0.f, 0.f, 0.f};
    const int nsteps = ctxq ? 8 : 16;
    for (int st = 0; st < nsteps; ++st) {
        const bool local = !ctxq && st < 8;
        const int kb = local ? latbase + 64 * (r0 + st) + cs : ctxbase + 32 * (ctxq ? st : st - 8);
        LDS_WAIT();
#pragma unroll
        for (int i = 0; i < 4; ++i) { const int piece = lane + 64 * i, key = piece >> 3, seg = piece & 7;
            const bf16x8 v = ld8(Pb + (size_t)(kb + key) * NP + C_NAV + 64 * h + 8 * seg);
#pragma unroll
            for (int e = 0; e < 8; ++e) Vt[(8 * seg + e) * 40 + key] = (bf16)v[e]; }
        f32x4 s[2];
#pragma unroll
        for (int kt = 0; kt < 2; ++kt) { const bf16* kp = Pb + (size_t)(kb + 16 * kt + ql) * NP + C_NAK + 64 * h + 8 * g;
            const f32x4 z = {0.f, 0.f, 0.f, 0.f}; s[kt] = MFMA16(ld8(kp), qf[0], z); s[kt] = MFMA16(ld8(kp + 32), qf[1], s[kt]); }
        float mx = -INFINITY;
#pragma unroll
        for (int kt = 0; kt < 2; ++kt)
#pragma unroll
            for (int j = 0; j < 4; ++j) {
                float v = s[kt][j] * (0.125f * LOG2E);
                if (local) { const int col = cs + 16 * kt + 4 * g + j; const bool ok = col >= c0 && col < c0 + 16;
                    const int bi = (r0 + st - r + 7) * 31 + min(max(col - cq + 15, 0), 30);
                    v = ok ? v + bias[bi] * LOG2E : -INFINITY; }
                s[kt][j] = v; mx = fmaxf(mx, v);
            }
        mx = fmaxf(mx, __shfl_xor(mx, 16)); mx = fmaxf(mx, __shfl_xor(mx, 32));
        const float mnew = fmaxf(mrun, mx), alpha = exp2f(mrun - mnew); mrun = mnew;
        float pv[8]; float ps = 0.f;
#pragma unroll
        for (int e = 0; e < 4; ++e) { pv[e] = exp2f(s[0][e] - mnew); pv[4 + e] = exp2f(s[1][e] - mnew); ps += pv[e] + pv[4 + e]; }
        lsum = lsum * alpha + ps;
        u32x4 w; w.x = pk2(pv[0], pv[1]); w.y = pk2(pv[2], pv[3]); w.z = pk2(pv[4], pv[5]); w.w = pk2(pv[6], pv[7]);
        const bf16x8 pt = __builtin_bit_cast(bf16x8, w);
        LDS_WAIT();
#pragma unroll
        for (int blk = 0; blk < 4; ++blk) { const LAS bf16* vp = Vt + (16 * blk + ql) * 40 + 4 * g; const bf16x8 vf = cat4(*(const LAS s16x4*)vp, *(const LAS s16x4*)(vp + 16));
            O[blk] = O[blk] * alpha; O[blk] = MFMA16(vf, pt, O[blk]); }
    }
    float lt = lsum; lt += __shfl_xor(lt, 16); lt += __shfl_xor(lt, 32);
    const float il = 1.f / lt;
    bf16* op = Pb + (size_t)rowq * NP + C_NAQ + 64 * h;
#pragma unroll
    for (int blk = 0; blk < 4; ++blk) { const f32x4 y = O[blk] * il; u32x2 w; w.x = pk2(y[0], y[1]); w.y = pk2(y[2], y[3]); *(u32x2*)(op + 16 * blk + 4 * g) = w; }
}

DI void mlstm_task(PP p, bf16* Pb, float* hbuf, LAS unsigned char* lds, int l, int bl, int h, int dir) {
    LAS bf16* Qs = (LAS bf16*)lds; LAS bf16* Ks = (LAS bf16*)(lds + 9216); LAS bf16* Vt = (LAS bf16*)(lds + 18432); LAS bf16* SW = (LAS bf16*)(lds + 29952);
    LAS bf16* Kt = (LAS bf16*)(lds + 39168); LAS bf16* Cb = (LAS bf16*)(lds + 48384); LAS float* Ct = (LAS float*)(lds + 59904); LAS float* NUM = (LAS float*)(lds + 80384);
    LAS float* vib = (LAS float*)(lds + 101120); LAS float* vb = vib + 64; LAS float* vmt = vib + 128; LAS float* vwi = vib + 192; LAS float* vwk = vib + 256; LAS float* vfb = vib + 320; LAS float* scal = vib + 384;
    const int tid = otid(), wave = tid >> 6, lane = tid & 63, g = lane >> 4, ql = lane & 15;
    const int latbase = bl * 2048, ctxbase = 32768 + bl * 256;
    float* hout = hbuf + (size_t)dir * HROWS * 256;
    __syncthreads();
    for (int e = tid; e < 80 * 64; e += 512) Ct[e] = 0.f;
    for (int e = tid; e < 80 * 72; e += 512) Cb[e] = 0;
    for (int e = tid; e < 16 * 72; e += 512) Vt[64 * 72 + e] = (e < 64) ? (bf16)0x3F80 : (bf16)0;
    if (tid == 0) scal[0] = 0.f;
    const float gbi = p->ml_gate_b[l * 16 + (dir ? 8 : 0) + h], gbf = p->ml_gate_b[l * 16 + (dir ? 12 : 4) + h];
    for (int ci = 0; ci < 36; ++ci) {
        const bool isc = ci < 4; const int cpos = isc ? ci * 64 : (ci - 4) * 64; const int len = isc ? 256 : 2048; const int base = isc ? ctxbase : latbase;
        __syncthreads();
        {
            const int t = tid >> 3, seg = tid & 7; const int pos = cpos + t; const int row = base + (dir ? len - 1 - pos : pos);
            const bf16* rp = Pb + (size_t)row * NP + 64 * h + 8 * seg;
            const bf16x8 q = ld8(rp + C_MLQ), k = ld8(rp + C_MLK), v = ld8(rp + C_MLV);
            float qv[8];
#pragma unroll
            for (int e = 0; e < 8; ++e) qv[e] = bf2f((unsigned short)q[e]) * 0.125f;
            u32x4 w; w.x = pk2(qv[0], qv[1]); w.y = pk2(qv[2], qv[3]); w.z = pk2(qv[4], qv[5]); w.w = pk2(qv[6], qv[7]);
            *(LAS u32x4*)(Qs + t * 72 + 8 * seg) = w; *(LAS bf16x8*)(Ks + t * 72 + 8 * seg) = k;
#pragma unroll
            for (int e = 0; e < 8; ++e) Vt[(8 * seg + e) * 72 + t] = (bf16)v[e];
            if (tid < 64) { const int pos2 = cpos + tid; const int row2 = base + (dir ? len - 1 - pos2 : pos2);
                const bf16* gp = Pb + (size_t)row2 * NP + C_MLIF; vib[tid] = bf2f(gp[(dir ? 8 : 0) + h]) + gbi; vfb[tid] = logsig(bf2f(gp[(dir ? 12 : 4) + h]) + gbf); }
        }
        __syncthreads();
        if (wave == 0) {
            const float mprev = scal[0]; const float ib = vib[lane];
            float b = vfb[lane];
#pragma unroll
            for (int o = 1; o < 64; o <<= 1) { const float t = __shfl_up(b, o); if (lane >= o) b += t; }
            float pm = ib - b;
#pragma unroll
            for (int o = 1; o < 64; o <<= 1) { const float t = __shfl_up(pm, o); if (lane >= o) pm = fmaxf(pm, t); }
            const float mt = fmaxf(b + mprev, b + pm);
            const float bend = __shfl(b, 63);
            const float klog = bend - b + ib;
            float km = klog;
#pragma unroll
            for (int o = 1; o < 64; o <<= 1) km = fmaxf(km, __shfl_xor(km, o));
            const float mnew = fmaxf(bend + mprev, km);
            vb[lane] = b; vmt[lane] = mt; vwi[lane] = expf(b + mprev - mt); vwk[lane] = expf(klog - mnew);
            if (lane == 0) { scal[1] = mnew; scal[2] = expf(bend + mprev - mnew); }
        }
        __syncthreads();
        {
            const int s = tid >> 3, seg = tid & 7; const float wk = vwk[s];
            const bf16x8 k = *(const LAS bf16x8*)(Ks + s * 72 + 8 * seg);
#pragma unroll
            for (int e = 0; e < 8; ++e) Kt[(8 * seg + e) * 72 + s] = (bf16)f2bf(bf2f((unsigned short)k[e]) * wk);
        }
        for (int tile = wave; tile < 16; tile += 8) {
            const int tm = tile >> 2, ts = tile & 3; f32x4 a = {0.f, 0.f, 0.f, 0.f};
            a = mm16(Qs, 72, 16 * tm, Ks, 72, 16 * ts, 64, a, ql, g);
            const int s = 16 * ts + ql; const float cs = vib[s] - vb[s];
#pragma unroll
            for (int j = 0; j < 4; ++j) { const int t = 16 * tm + 4 * g + j; const float w = (s <= t) ? expf(vb[t] + cs - vmt[t]) : 0.f; SW[t * 72 + s] = (bf16)f2bf(a[j] * w); }
        }
        __syncthreads();
        for (int tile = wave; tile < 20; tile += 8) {
            const int tm = tile / 5, tv = tile % 5; f32x4 a1 = {0.f, 0.f, 0.f, 0.f}, a2 = {0.f, 0.f, 0.f, 0.f};
            a1 = mm16(SW, 72, 16 * tm, Vt, 72, 16 * tv, 64, a1, ql, g);
            a2 = mm16(Qs, 72, 16 * tm, Cb, 72, 16 * tv, 64, a2, ql, g);
#pragma unroll
            for (int j = 0; j < 4; ++j) { const int t = 16 * tm + 4 * g + j; NUM[t * 81 + 16 * tv + ql] = a1[j] + vwi[t] * a2[j]; }
        }
        {
            const float decay = scal[2];
            for (int tile = wave; tile < 20; tile += 8) {
                const int tv = tile >> 2, td = tile & 3; f32x4 a = {0.f, 0.f, 0.f, 0.f};
                a = mm16(Vt, 72, 16 * tv, Kt, 72, 16 * td, 64, a, ql, g);
#pragma unroll
                for (int j = 0; j < 4; ++j) { const int idx = (16 * tv + 4 * g + j) * 64 + 16 * td + ql; Ct[idx] = decay * Ct[idx] + a[j]; }
            }
        }
        __syncthreads();
        {
            const int t = tid >> 3, seg = tid & 7; const int pos = cpos + t; const int row = base + (dir ? len - 1 - pos : pos);
            const float den = fmaxf(fabsf(NUM[t * 81 + 64]), expf(-vmt[t])); const float id = 1.f / den;
            float* op = hout + (size_t)row * 256 + 64 * h + 8 * seg;
            f32x4 o0, o1;
#pragma unroll
            for (int e = 0; e < 4; ++e) { o0[e] = NUM[t * 81 + 8 * seg + e] * id; o1[e] = NUM[t * 81 + 8 * seg + 4 + e] * id; }
            *(f32x4*)op = o0; *(f32x4*)(op + 4) = o1;
            for (int e = tid; e < 80 * 64; e += 512) Cb[(e >> 6) * 72 + (e & 63)] = (bf16)f2bf(Ct[e]);
            if (tid == 0) scal[0] = scal[1];
        }
    }
}

DI void gla_task(PP p, bf16* Pb, float* hbuf, LAS unsigned char* lds, int l, int bl, int h, int dir) {
    LAS bf16* Qg = (LAS bf16*)lds; LAS bf16* Kg = (LAS bf16*)(lds + 5120); LAS bf16* Vt = (LAS bf16*)(lds + 10240); LAS bf16* ATT = (LAS bf16*)(lds + 19456);
    LAS bf16* Kt = (LAS bf16*)(lds + 28672); LAS bf16* Sb = (LAS bf16*)(lds + 33280); LAS float* St = (LAS float*)(lds + 38400); LAS float* Bc = (LAS float*)(lds + 46592);
    LAS float* Qr = (LAS float*)(lds + 55040); LAS float* Kr = (LAS float*)(lds + 63488); LAS float* Av = (LAS float*)(lds + 71936); LAS float* Wa = (LAS float*)(lds + 76032); LAS float* ba = (LAS float*)(lds + 78080);
    const int tid = otid(), wave = tid >> 6, lane = tid & 63, g = lane >> 4, ql = lane & 15;
    const int latbase = bl * 2048, ctxbase = 32768 + bl * 256;
    float* hout = hbuf + (size_t)(2 + dir) * HROWS * 256;
    __syncthreads();
    for (int e = tid; e < 64 * 32; e += 512) St[e] = 0.f;
    for (int e = tid; e < 64 * 40; e += 512) Sb[e] = 0;
    { const int r = tid >> 5, d = tid & 31; Wa[tid] = p->gla_w_a2[(size_t)((l * 2 + dir) * 16 + r) * 128 + 32 * h + d]; if (tid < 32) ba[tid] = p->gla_b_a[(l * 2 + dir) * 128 + 32 * h + tid]; }
    const float qs = 0.17677669529663687f;
    for (int ci = 0; ci < 36; ++ci) {
        const bool isc = ci < 4; const int cpos = isc ? ci * 64 : (ci - 4) * 64; const int len = isc ? 256 : 2048; const int base = isc ? ctxbase : latbase;
        __syncthreads();
        {
            const int t = tid >> 3, seg = tid & 7; const int pos = cpos + t; const int row = base + (dir ? len - 1 - pos : pos);
            const bf16* rp = Pb + (size_t)row * NP;
            const bf16x8 v = ld8(rp + C_GLV + 64 * h + 8 * seg);
#pragma unroll
            for (int e = 0; e < 8; ++e) Vt[(8 * seg + e) * 72 + t] = (bf16)v[e];
            if (seg < 4) { const bf16x8 q = ld8(rp + C_GLQ + 32 * h + 8 * seg);
#pragma unroll
                for (int e = 0; e < 8; ++e) Qr[t * 33 + 8 * seg + e] = bf2f((unsigned short)q[e]); }
            else { const bf16x8 k = ld8(rp + C_GLK + 32 * h + 8 * (seg - 4));
#pragma unroll
                for (int e = 0; e < 8; ++e) Kr[t * 33 + 8 * (seg - 4) + e] = bf2f((unsigned short)k[e]); }
            if (tid < 128) { const int t2 = tid >> 1, hf = tid & 1; const int pos2 = cpos + t2; const int row2 = base + (dir ? len - 1 - pos2 : pos2);
                const bf16x8 a = ld8(Pb + (size_t)row2 * NP + C_GLA + 16 * dir + 8 * hf);
#pragma unroll
                for (int e = 0; e < 8; ++e) Av[t2 * 16 + 8 * hf + e] = bf2f((unsigned short)a[e]); }
        }
        __syncthreads();
        {
            const int t = tid >> 3, d0 = (tid & 7) * 4;
#pragma unroll
            for (int e = 0; e < 4; ++e) { float z = ba[d0 + e];
#pragma unroll
                for (int r = 0; r < 16; ++r) z += Av[t * 16 + r] * Wa[r * 32 + d0 + e];
                Bc[t * 33 + d0 + e] = logsig(z) * (1.f / 16.f); }
        }
        __syncthreads();
#pragma unroll
        for (int e = 0; e < 4; ++e) { const int d = 4 * wave + e; float b = Bc[lane * 33 + d];
#pragma unroll
            for (int o = 1; o < 64; o <<= 1) { const float t = __shfl_up(b, o); if (lane >= o) b += t; }
            Bc[lane * 33 + d] = b; }
        __syncthreads();
        {
            const int t = tid >> 3, d0 = (tid & 7) * 4;
#pragma unroll
            for (int e = 0; e < 4; ++e) { const int d = d0 + e; const float b = Bc[t * 33 + d], be = Bc[63 * 33 + d]; const float q = Qr[t * 33 + d], k = Kr[t * 33 + d];
                Qg[t * 40 + d] = (bf16)f2bf(q * qs * expf(b)); Kg[t * 40 + d] = (bf16)f2bf(k * expf(-b)); Kt[d * 72 + t] = (bf16)f2bf(k * expf(be - b)); }
        }
        __syncthreads();
        for (int tile = wave; tile < 16; tile += 8) {
            const int tm = tile >> 2, ts = tile & 3; f32x4 a = {0.f, 0.f, 0.f, 0.f};
            a = mm16(Qg, 40, 16 * tm, Kg, 40, 16 * ts, 32, a, ql, g);
            const int s = 16 * ts + ql;
#pragma unroll
            for (int j = 0; j < 4; ++j) { const int t = 16 * tm + 4 * g + j; ATT[t * 72 + s] = (bf16)f2bf(s <= t ? a[j] : 0.f); }
        }
        __syncthreads();
        for (int tile = wave; tile < 16; tile += 8) {
            const int tm = tile >> 2, tv = tile & 3; f32x4 a = {0.f, 0.f, 0.f, 0.f};
            a = mm16(ATT, 72, 16 * tm, Vt, 72, 16 * tv, 64, a, ql, g);
            a = mm16(Qg, 40, 16 * tm, Sb, 40, 16 * tv, 32, a, ql, g);
#pragma unroll
            for (int j = 0; j < 4; ++j) { const int t = 16 * tm + 4 * g + j; const int pos = cpos + t; const int row = base + (dir ? len - 1 - pos : pos);
                hout[(size_t)row * 256 + 64 * h + 16 * tv + ql] = a[j]; }
        }
        {
            const int tv = wave >> 1, td = wave & 1; f32x4 a = {0.f, 0.f, 0.f, 0.f};
            a = mm16(Vt, 72, 16 * tv, Kt, 72, 16 * td, 64, a, ql, g);
            const int d = 16 * td + ql; const float dec = expf(Bc[63 * 33 + d]);
#pragma unroll
            for (int j = 0; j < 4; ++j) { const int idx = (16 * tv + 4 * g + j) * 32 + d; St[idx] = dec * St[idx] + a[j]; }
        }
        __syncthreads();
        for (int e = tid; e < 64 * 32; e += 512) Sb[(e >> 5) * 40 + (e & 31)] = (bf16)f2bf(St[e]);
    }
}

DI void mixers_phase(PP p, LAS unsigned char* lds, int l, bool ctx_out) {
    bf16* Pb = (bf16*)(p->ws + WS_BIG); float* hbuf = (float*)(p->ws + WS_HBUF);
    const int tid = otid(), wave = tid >> 6;
    const float lam_init = 0.8f - 0.6f * expf(-0.3f * (float)l);
    float lam;
    { const float* dl = p->da_lambda + l * 128; float s1 = 0.f, s2 = 0.f;
        for (int i = 0; i < 32; ++i) { s1 += dl[i] * dl[32 + i]; s2 += dl[64 + i] * dl[96 + i]; }
        lam = expf(s1) - expf(s2) + lam_init; }
    const int n_scan = 256, n_da = 512, n_dac = ctx_out ? 64 : 0, n_na = 1024, n_nac = ctx_out ? 128 : 0;
    const int total = n_scan + n_da + n_dac + n_na + n_nac;
    for (int it = obid(); it < total; it += ogrid()) {
        int i = it;
        if (i < 128) { mlstm_task(p, Pb, hbuf, lds, l, i >> 3, (i >> 1) & 3, i & 1); continue; }
        if (i < 256) { i -= 128; gla_task(p, Pb, hbuf, lds, l, i >> 3, (i >> 1) & 3, i & 1); continue; } i -= 256;
        if (i < n_da) { da_item(p, Pb, lds, l, false, i >> 5, (i >> 3) & 3, i & 7, lam, lam_init); continue; } i -= n_da;
        if (i < n_dac) { da_item(p, Pb, lds, l, true, i >> 2, i & 3, 0, lam, lam_init); continue; } i -= n_dac;
        LAS float* bias = (LAS float*)lds; LAS bf16* Vt = (LAS bf16*)(lds + 2048 + wave * 5120);
        if (i < n_na) {
            const int bl = i >> 6, h = (i >> 4) & 3, rp = i & 15;
            __syncthreads();
            for (int e = tid; e < 465; e += 512) bias[e] = p->na_rpb[(size_t)((l * 4 + h) * 15) * 31 + e];
            __syncthreads();
            na_wave(p, Pb, bias, Vt, false, bl, h, 2 * rp + (wave >> 2), wave & 3, 0);
            continue;
        }
        i -= n_na;
        { const int bl = i >> 3, h = (i >> 1) & 3, hf = i & 1; __syncthreads(); na_wave(p, Pb, bias, Vt, true, bl, h, 0, 0, 128 * hf + 16 * wave); }
    }
}

DI void finish_phase(PP p, int l, bool ctx_out) {
    bf16* Pb = (bf16*)(p->ws + WS_BIG); const float* hbuf = (const float*)(p->ws + WS_HBUF);
    const int wave = otid() >> 6, lane = otid() & 63;
    const int gw = obid() * 8 + wave, NGW = ogrid() * 8;
    const int nrows = ctx_out ? HROWS : 32768;
    for (int r = gw; r < nrows; r += NGW) {
#pragma unroll
        for (int br = 0; br < 2; ++br) {
            const float* hf = hbuf + (size_t)(2 * br) * HROWS * 256 + (size_t)r * 256 + 4 * lane; const float* hb = hf + (size_t)HROWS * 256;
            f32x4 v = *(const f32x4*)hf + *(const f32x4*)hb;
            if (br == 0) { float s = (v[0] + v[1]) + (v[2] + v[3]); s += __shfl_xor(s, 1); s += __shfl_xor(s, 2); s += __shfl_xor(s, 4); s += __shfl_xor(s, 8); v = v - s * (1.f / 64.f); }
            float q = (v[0] * v[0] + v[1] * v[1]) + (v[2] * v[2] + v[3] * v[3]); q += __shfl_xor(q, 1); q += __shfl_xor(q, 2); q += __shfl_xor(q, 4); q += __shfl_xor(q, 8);
            const float rn = 1.f / sqrtf(q * (1.f / 64.f) + 1e-6f);
            const f32x4 gg = *(const f32x4*)((br == 0 ? p->ml_norm_g : p->gla_norm_g) + l * 256 + 4 * lane);
            bf16* gp = Pb + (size_t)r * NP + (br == 0 ? C_MLO : C_GLG) + 4 * lane;
            const u32x2 gw2 = *(const u32x2*)gp;
            const float gt[4] = {bflo(gw2.x), bfhi(gw2.x), bflo(gw2.y), bfhi(gw2.y)};
            float y[4];
#pragma unroll
            for (int e = 0; e < 4; ++e) { const float a = sigm(gt[e]); y[e] = (br == 0 ? a : a * gt[e]) * v[e] * rn * gg[e]; }
            u32x2 w; w.x = pk2(y[0], y[1]); w.y = pk2(y[2], y[3]); *(u32x2*)gp = w;
        }
    }
}

__global__ void __launch_bounds__(512) fwd_megakernel(Params pv, int ph_lo, int ph_hi) {
    extern __shared__ __attribute__((aligned(16))) unsigned char lds_raw[];
    LAS unsigned char* lds = (LAS unsigned char*)lds_raw;
    cg::grid_group grid = cg::this_grid();
    PP p = (PP)__builtin_amdgcn_kernarg_segment_ptr();
    if (ph_hi > 34) ph_hi = 34;
#pragma unroll 1
    for (int ph = ph_lo; ph < ph_hi; ++ph) {
        bf16* hmod = (bf16*)(p->ws + WS_HMOD); bf16* big = (bf16*)(p->ws + WS_BIG);
        if (ph == 0) p0_prologue(p, lds);
        else if (ph == 1) rows_phase(p, 0, RALL, 0, 0, true, 0, 0, 1);
        else {
            const int l = (ph - 2) >> 4, k = (ph - 2) & 15;
            const bool ctx_out = (l == 0);
            const int nrow = ctx_out ? RALL : RLAT, npan = nrow / 256;
            if (k == 0 || k == 13) {
                const int s = k == 0 ? 0 : 1;
                pg8::ProbFfnIn q; q.K = 1024; q.lda = 1024; q.o.init(k == 0 ? 288 : npan, 22); q.A = hmod; q.Bt = (const bf16*)(p->ws + WS_WIN) + (size_t)(l * 2 + s) * 5632 * 1024; q.act = big;
                pg8::gemm_phase(lds, q);
            } else if (k == 1 || k == 11 || k == 14) {
                pg8::ProbRes q; q.prm = p; q.layer = l; q.first = (l == 0 && k == 1);
                if (k == 11) { q.K = 1024; q.lda = 1024; q.A = hmod; q.Bt = (const bf16*)(p->ws + WS_WO) + (size_t)l * 1024 * 1024; q.gidx = 5; q.coef = 1.0f; }
                else { q.K = DFF; q.lda = DFF; q.A = big; q.Bt = (const bf16*)(p->ws + WS_WOUTF) + (size_t)(l * 2 + (k == 1 ? 0 : 1)) * 1024 * DFF; q.gidx = k == 1 ? 2 : 8; q.coef = 0.5f; }
                q.o.init(k == 1 ? 288 : npan, 4);
                pg8::gemm_phase(lds, q);
            } else if (k == 2) rows_phase(p, 1, RALL, l, 0, true, l, 3, 4);
            else if (k == 12) rows_phase(p, 1, nrow, l, 1, true, l, 6, 7);
            else if (k == 15) rows_phase(p, 1, nrow, l, 2, l == 0, 1, 0, 1);
            else {
                const int half = (k - 3) >> 2, kk = (k - 3) & 3;
                if (kk == 0) { pg8::ProbMix q; q.K = 1024; q.lda = 1024; q.o.init(144, 30); q.A = hmod; q.Bt = (const bf16*)(p->ws + WS_WMIX) + (size_t)l * NP * 1024; q.Pb = big; q.half = half; pg8::gemm_phase(lds, q); }
                else if (kk == 1) mixers_phase(p, lds, l, ctx_out);
                else if (kk == 2) finish_phase(p, l, ctx_out);
                else { pg8::ProbMerge q; q.K = 256; q.lda = NP; q.o.init(ctx_out ? 144 : 128, 4); q.Pb = big; q.Wb = (const bf16*)(p->ws + WS_WB) + (size_t)l * 4 * 1024 * 256; q.merged = hmod; q.half = half; pg8::gemm_phase(lds, q); }
            }
        }
        if (ph + 1 < ph_hi) grid.sync();
    }
}

extern "C" void kernel_launch(void* const* d_in, const int* in_sizes, int n_in, void* d_out, int out_size, void* d_ws, size_t ws_size, hipStream_t stream) {
    static int grid = 0;
    if (grid == 0) {
        int dev = 0, cus = 0, per_cu = 0;
        hipGetDevice(&dev);
        hipDeviceGetAttribute(&cus, hipDeviceAttributeMultiprocessorCount, dev);
        hipFuncSetAttribute((const void*)fwd_megakernel, hipFuncAttributeMaxDynamicSharedMemorySize, LDS_BYTES);
        hipOccupancyMaxActiveBlocksPerMultiprocessor(&per_cu, (const void*)fwd_megakernel, 512, LDS_BYTES);
        if (per_cu < 1) per_cu = 1;
        grid = cus * per_cu;
        if (ws_size < WS_END) fprintf(stderr, "kernel_launch: workspace too small: %zu < %zu\n", ws_size, (size_t)WS_END);
    }
    Params p{};
    const float** pp = (const float**)&p;
    for (int i = 0; i < 21; ++i) pp[i] = (const float*)d_in[i];
    p.out = (float*)d_out; p.ws = (unsigned char*)d_ws;
    int lo = 0, hi = 1000;
    void* args[] = {&p, &lo, &hi};
    hipError_t e = hipLaunchCooperativeKernel((const void*)fwd_megakernel, dim3(grid), dim3(512), args, LDS_BYTES, stream);
    if (e != hipSuccess) fprintf(stderr, "cooperative launch failed: %s (grid %d)\n", hipGetErrorString(e), grid);
}
```

```cpp
#include <hip/hip_runtime.h>
#include <hip/hip_cooperative_groups.h>
#include <cstdio>
namespace cg = cooperative_groups;

#define LAS __attribute__((address_space(3)))
typedef unsigned short bf16;
typedef short bf16x8 __attribute__((ext_vector_type(8)));
typedef short s16x4 __attribute__((ext_vector_type(4)));
typedef float f32x4 __attribute__((ext_vector_type(4)));
typedef unsigned u32x4 __attribute__((ext_vector_type(4)));
typedef unsigned u32x2 __attribute__((ext_vector_type(2)));
#define DI __device__ __forceinline__
#define LDS_WAIT() asm volatile("s_waitcnt lgkmcnt(0)" ::: "memory")
#define MFMA16(a, b, c) __builtin_amdgcn_mfma_f32_16x16x32_bf16((a), (b), (c), 0, 0, 0)

constexpr int D = 1024, SEQ = 2048, TCTX = 256, DFF = 2816;
constexpr int RLAT = 65536, RALL = 73728;
constexpr int NP = 7680;
constexpr int C_NAQ = 0, C_NAK = 256, C_NAV = 512, C_MLQ = 768, C_MLK = 1024, C_MLV = 1280, C_MLO = 1536, C_GLQ = 1792, C_GLK = 1920, C_GLV = 2048,
              C_GLG = 2304, C_DAQ = 2560, C_DAK = 2816, C_DAV = 3072, C_MLIF = 3328, C_GLA = 3344, C_GATE = 3584;
constexpr int HROWS = 36864;
constexpr float ALPHA = 1.41421356237f;
constexpr float LOG2E = 1.44269504089f;

constexpr size_t MiB = 1u << 20;
constexpr size_t WS_MODS = 1 * MiB, WS_WIN = 4 * MiB, WS_WOUTF = 48 * MiB, WS_WMIX = 70 * MiB, WS_WB = 100 * MiB, WS_WO = 104 * MiB, WS_LATC = 108 * MiB,
                 WS_HMOD = 140 * MiB, WS_BIG = 284 * MiB, WS_HBUF = WS_BIG + 540 * MiB, WS_END = WS_HBUF + 144 * MiB;
constexpr size_t WS_BAR = 768 * 1024;
constexpr int LDS_BYTES = 135168;

#ifndef PROBE_MODE
#define PROBE_MODE 0
#endif
#define DRY_MASK 0
#define REPG 0
#define GEMM_REP(q) do { int nrep = REPG ? 2 : 1; asm volatile("" : "+s"(nrep)); _Pragma("unroll 1") for (int rep = 0; rep < nrep; ++rep) { pg8::gemm_phase(lds, q); if (rep + 1 < nrep) xcd_barrier(bar); } } while (0)
#define PROBE_A 5
#define PROBE_B 2
#define PROBE_BLOCK 0
struct Params {
    const float *x, *c, *ctx, *c_ctx, *w_ada, *b_ada, *ln_g, *ln_b, *ffn_w_in, *ffn_w_out, *w_mix_in, *na_rpb, *ml_gate_b, *ml_norm_g, *gla_w_a2, *gla_b_a,
        *gla_norm_g, *da_lambda, *da_norm_g, *w_branch, *w_out;
    float* out; unsigned char* ws;
};

typedef const __attribute__((address_space(4))) Params* PP;
DI int otid() { int t = threadIdx.x; asm volatile("" : "+v"(t)); return t; }
DI int obid() { int t = blockIdx.x; asm volatile("" : "+s"(t)); return t; }
DI int ogrid() { int t = gridDim.x; asm volatile("" : "+s"(t)); return t; }
typedef __bf16 hbf2 __attribute__((ext_vector_type(2)));
typedef float f32x2 __attribute__((ext_vector_type(2)));
DI unsigned pk2(float lo, float hi) { const f32x2 v = {lo, hi}; return __builtin_bit_cast(unsigned, __builtin_convertvector(v, hbf2)); }
DI unsigned f2bf(float f) { return pk2(f, 0.f) & 0xffffu; }
DI float bf2f(unsigned short b) { return __builtin_bit_cast(float, ((unsigned)b) << 16); }
DI float bflo(unsigned w) { return __builtin_bit_cast(float, w << 16); }
DI float bfhi(unsigned w) { return __builtin_bit_cast(float, w & 0xffff0000u); }
DI float sigm(float x) { return __builtin_amdgcn_rcpf(1.f + __expf(-x)); }
DI float logsig(float x) { return fminf(x, 0.f) - log1pf(expf(-fabsf(x))); }
DI float logsig_fast(float x) { return fminf(x, 0.f) - __logf(1.f + __expf(-fabsf(x))); }
DI int grow_of(int pm, int half) { return half < 0 ? pm * 256 : (pm < 128 ? half * 32768 + pm * 256 : RLAT + half * 4096 + (pm - 128) * 256); }
DI float* latrow(PP p, int r) { return r < RLAT ? p->out + (size_t)r * D : (float*)(p->ws + WS_LATC) + (size_t)(r - RLAT) * D; }
DI bf16* ybfrow(PP p, int r) { return r < RLAT ? (bf16*)p->out + (size_t)r * D : (bf16*)(p->ws + WS_LATC) + (size_t)(r - RLAT) * D; }
DI float* yfinrow(PP p, int r) { return (float*)(p->ws + WS_BIG + 400 * MiB) + (size_t)r * D; }
DI const float* xrow(PP p, int r) { return r < RLAT ? p->x + (size_t)r * D : p->ctx + (size_t)(r - RLAT) * D; }
DI const float* modrow(PP p, int l, int r) { return (const float*)(p->ws + WS_MODS) + (size_t)(l * 33 + (r < RLAT ? (r >> 11) : 32)) * 9216; }

namespace pg8 {
constexpr int BM = 256, BK = 64, HALF = 128, HTB = HALF * BK * 2, NXCD = 8, WGM = 8;
DI int lds_byte(int r, int c) { const int st = (r >> 4) * 2 + (c >> 5), rr = r & 15, cc = c & 31, ob = rr * 64 + cc * 2; return st * 1024 + (ob ^ (((ob >> 9) & 1) << 5)); }
DI void stage_rc(int b, int& R, int& C) { const int st = b / 1024, sb = b % 1024, swz = sb ^ (((sb >> 9) & 1) << 5); R = (st >> 1) * 16 + swz / 64; C = (st & 1) * 32 + (swz % 64) / 2; }
DI int perm32(int rho) { const int n = rho >> 4, i = rho & 15; return 8 * (i >> 2) + 4 * n + (i & 3); }
struct Unit { int pm, pn, j; };
struct Order {
    int nM, nN, nwg, G, c;
    DI void init(int nM_, int nN_) { nM = nM_; nN = nN_; nwg = nM * nN; G = ogrid(); c = obid(); }
    DI bool tile(long L, Unit& u) const {
        if (L >= nwg) return false;
        int wgid = (int)L; { const int q = nwg / NXCD, r = nwg % NXCD, xcd = wgid % NXCD, off = wgid / NXCD; wgid = (xcd < r ? xcd * (q + 1) : r * (q + 1) + (xcd - r) * q) + off; }
        const int nig = WGM * nN, gid = wgid / nig, fm = gid * WGM, gsz = (nM - fm) < WGM ? (nM - fm) : WGM;
        u.pm = fm + ((wgid % nig) % gsz); u.pn = (wgid % nig) / gsz; u.j = 0; return true;
    }
};
typedef f32x4 Acc[2][2][4][2];

template <class P>
DI void gemm_phase(LAS unsigned char* lds, const P& p) {
    const int tid = otid(), wid = __builtin_amdgcn_readfirstlane(tid >> 6), lane = tid & 63, wr = wid >> 2, wc = wid & 3, fr = lane & 15, fq = lane >> 4;
    const int K = p.K, nt = K / BK; const int lda = p.lda;
    unsigned voffA[2], voffB[2];
#pragma unroll
    for (int i = 0; i < 2; ++i) { int R, C; stage_rc(tid * 16 + i * 8192, R, C); const int Rb = P::PERM ? ((R & ~31) + perm32(R & 31)) : R;
        voffA[i] = (unsigned)(R * lda + C) * 2u; voffB[i] = (unsigned)(Rb * K + C) * 2u; }
    const size_t kstep = (size_t)(BK * 2);
    const size_t hstepA = (size_t)HALF * lda * 2, hstepB = (size_t)HALF * K * 2;
    const unsigned ldsw = (unsigned)wid * 1024u;
    const int aoff = lds_byte(wr * 64 + fr, fq * 8), boff = lds_byte(wc * 32 + fr, fq * 8);
#define PG8_SA(b, h) (((b) * 2 + (h)) * HTB)
#define PG8_SB(b, h) ((4 + (b) * 2 + (h)) * HTB)
#define PG8_STAGE(bufoff, gbase, voff) do { _Pragma("unroll") for (int _i = 0; _i < 2; ++_i) \
        __builtin_amdgcn_global_load_lds((const unsigned*)((const char*)(gbase) + (voff)[_i]), (LAS unsigned*)(lds + (bufoff) + ldsw + _i * 8192), 16, 0, 0); } while (0)
#define PG8_LDA(dst, b, h) do { _Pragma("unroll") for (int m = 0; m < 4; ++m) _Pragma("unroll") for (int k = 0; k < 2; ++k) dst[m][k] = *(const LAS bf16x8*)(lds + PG8_SA(b, h) + aoff + m * 2048 + k * 1024); } while (0)
#define PG8_LDB(dst, b, h) do { _Pragma("unroll") for (int n = 0; n < 2; ++n) _Pragma("unroll") for (int k = 0; k < 2; ++k) dst[n][k] = *(const LAS bf16x8*)(lds + PG8_SB(b, h) + boff + n * 2048 + k * 1024); } while (0)
#define PG8_MMA(ai, bj, At, Bt) do { __builtin_amdgcn_s_setprio(1); _Pragma("unroll") for (int m = 0; m < 4; ++m) _Pragma("unroll") for (int n = 0; n < 2; ++n) _Pragma("unroll") for (int k = 0; k < 2; ++k) \
        acc[ai][bj][m][n] = __builtin_amdgcn_mfma_f32_16x16x32_bf16(Bt[n][k], At[m][k], acc[ai][bj][m][n], 0, 0, 0); __builtin_amdgcn_s_setprio(0); } while (0)
#define PG8_WAIT_V(n) asm volatile("s_waitcnt vmcnt(" #n ")" ::: "memory")
#define PG8_WAIT_L(n) asm volatile("s_waitcnt lgkmcnt(" #n ")" ::: "memory")
#define PG8_BAR __builtin_amdgcn_s_barrier()
#define PG8_SCHED __builtin_amdgcn_sched_barrier(0)
    Unit cur, nxt; int ui = 0;
    if (!p.next(0, cur)) return;
    Acc acc;
#pragma unroll
    for (int a = 0; a < 2; ++a)
#pragma unroll
        for (int b = 0; b < 2; ++b)
#pragma unroll
            for (int m = 0; m < 4; ++m)
#pragma unroll
                for (int n = 0; n < 2; ++n) acc[a][b][m][n] = (f32x4){0.f, 0.f, 0.f, 0.f};
    bf16x8 At[4][2], B0[2][2], B1[2][2];
    const char* cA = p.abase(cur); const char* cB = p.bbase(cur);
    PG8_STAGE(PG8_SB(0, 0), cB, voffB); PG8_STAGE(PG8_SA(0, 0), cA, voffA); PG8_STAGE(PG8_SB(0, 1), cB + hstepB, voffB); PG8_STAGE(PG8_SA(0, 1), cA + hstepA, voffA);
    if (wr == 1) PG8_BAR;
    PG8_WAIT_V(4); PG8_BAR;
    PG8_STAGE(PG8_SB(1, 0), cB + kstep, voffB); PG8_STAGE(PG8_SA(1, 0), cA + kstep, voffA); PG8_STAGE(PG8_SB(1, 1), cB + hstepB + kstep, voffB);
    PG8_WAIT_V(6); PG8_BAR;
    for (;;) {
        const bool has_next = p.next(ui + 1, nxt);
        const char* nA = has_next ? p.abase(nxt) : cA; const char* nB = has_next ? p.bbase(nxt) : cB;
        for (int t = 0; t < nt; t += 2) {
            const bool last = (t == nt - 2);
            const char* a1 = cA + (size_t)(t + 1) * kstep;
            const char* a2 = last ? nA : cA + (size_t)(t + 2) * kstep; const char* b2 = last ? nB : cB + (size_t)(t + 2) * kstep;
            const char* a3 = a2 + kstep; const char* b3 = b2 + kstep;
            PG8_LDB(B0, 0, 0); PG8_SCHED; PG8_LDA(At, 0, 0); PG8_STAGE(PG8_SA(1, 1), a1 + hstepA, voffA);
            PG8_WAIT_L(8); PG8_BAR; PG8_WAIT_L(0); PG8_MMA(0, 0, At, B0); PG8_BAR; PG8_SCHED;
            PG8_LDB(B1, 0, 1); PG8_STAGE(PG8_SB(0, 0), b2, voffB);
            PG8_BAR; PG8_WAIT_L(0); PG8_MMA(0, 1, At, B1); PG8_BAR;
            PG8_LDA(At, 0, 1); PG8_STAGE(PG8_SA(0, 0), a2, voffA);
            PG8_BAR; PG8_WAIT_L(0); PG8_MMA(1, 0, At, B0); PG8_BAR; PG8_SCHED;
            PG8_STAGE(PG8_SB(0, 1), b2 + hstepB, voffB);
            PG8_WAIT_V(6); PG8_BAR; PG8_MMA(1, 1, At, B1); PG8_BAR;
            PG8_LDB(B0, 1, 0); PG8_SCHED; PG8_LDA(At, 1, 0); PG8_STAGE(PG8_SA(0, 1), a2 + hstepA, voffA);
            PG8_WAIT_L(8); PG8_BAR; PG8_WAIT_L(0); PG8_MMA(0, 0, At, B0); PG8_BAR; PG8_SCHED;
            PG8_LDB(B1, 1, 1); PG8_STAGE(PG8_SB(1, 0), b3, voffB);
            PG8_BAR; PG8_WAIT_L(0); PG8_MMA(0, 1, At, B1); PG8_BAR;
            PG8_LDA(At, 1, 1); PG8_STAGE(PG8_SA(1, 0), a3, voffA);
            PG8_BAR; PG8_WAIT_L(0); PG8_MMA(1, 0, At, B0); PG8_BAR; PG8_SCHED;
            PG8_STAGE(PG8_SB(1, 1), b3 + hstepB, voffB);
            PG8_WAIT_V(6); PG8_BAR; PG8_MMA(1, 1, At, B1); PG8_BAR;
        }
        p.epi(acc, cur, wr, wc, fr, fq);
        if (!has_next) break;
        if (!P::KEEP) {
#pragma unroll
            for (int a = 0; a < 2; ++a)
#pragma unroll
                for (int b = 0; b < 2; ++b)
#pragma unroll
                    for (int m = 0; m < 4; ++m)
#pragma unroll
                        for (int n = 0; n < 2; ++n) acc[a][b][m][n] = (f32x4){0.f, 0.f, 0.f, 0.f};
        }
        cur = nxt; cA = nA; cB = nB; ++ui;
    }
    PG8_WAIT_V(0);
    if (wr == 0) PG8_BAR;
    PG8_BAR;
#undef PG8_SA
#undef PG8_SB
#undef PG8_STAGE
#undef PG8_LDA
#undef PG8_LDB
#undef PG8_MMA
#undef PG8_WAIT_V
#undef PG8_WAIT_L
#undef PG8_BAR
#undef PG8_SCHED
}

struct ProbFfnIn {
    static constexpr bool PERM = true, KEEP = false;
    int K, lda; Order o; const bf16* A; const bf16* Bt; bf16* act;
    DI bool next(int i, Unit& u) const { return o.tile((long)i * o.G + o.c, u); }
    DI const char* abase(const Unit& u) const { return (const char*)(A + (size_t)u.pm * 256 * lda); }
    DI const char* bbase(const Unit& u) const { return (const char*)(Bt + (size_t)u.pn * 256 * K); }
    DI void epi(Acc& acc, const Unit& u, int wr, int wc, int fr, int fq) const {
#pragma unroll
        for (int ai = 0; ai < 2; ++ai)
#pragma unroll
            for (int m = 0; m < 4; ++m) {
                const int row = u.pm * 256 + ai * 128 + wr * 64 + m * 16 + fr;
                float o8[8];
#pragma unroll
                for (int n = 0; n < 2; ++n)
#pragma unroll
                    for (int e = 0; e < 4; ++e) { const float a = acc[ai][0][m][n][e], b = acc[ai][1][m][n][e]; o8[n * 4 + e] = a * sigm(a) * b; }
                u32x4 w; w.x = pk2(o8[0], o8[1]); w.y = pk2(o8[2], o8[3]); w.z = pk2(o8[4], o8[5]); w.w = pk2(o8[6], o8[7]);
                *(u32x4*)(act + (size_t)row * DFF + u.pn * 128 + wc * 32 + 8 * fq) = w;
            }
    }
};
struct ProbRes {
    static constexpr bool PERM = true, KEEP = false;
    int K, lda; Order o; const bf16* A; const bf16* Bt; PP prm; int layer, gidx, first, lnidx, dry, fin; float coef;
    DI bool next(int i, Unit& u) const { return o.tile((long)i * o.G + o.c, u); }
    DI const char* abase(const Unit& u) const { return (const char*)(A + (size_t)u.pm * 256 * lda); }
    DI const char* bbase(const Unit& u) const { return (const char*)(Bt + (size_t)u.pn * 256 * K); }
    DI void epi(Acc& acc, const Unit& u, int wr, int wc, int fr, int fq) const {
        int pm_ = u.pm, pn_ = u.pn; asm volatile("" : "+s"(pm_), "+s"(pn_));
        const int r0 = pm_ * 256;
        const float* gate = modrow(prm, layer, r0) + gidx * D;
        bf16* yb = ybfrow(prm, r0); bf16* yo = fin ? (bf16*)yfinrow(prm, 0) + (size_t)r0 * D : yb;
        const f32x2* stats = (const f32x2*)(prm->ws) + r0;
        const int col0 = pn_ * 256 + wc * 32 + 8 * fq;
        const float* lg = prm->ln_g + (size_t)(first ? 0 : lnidx) * D; const float* lb = prm->ln_b + (size_t)(first ? 0 : lnidx) * D;
#pragma unroll
        for (int bj = 0; bj < 2; ++bj) {
            const int c = col0 + bj * 128;
            f32x4 g4[2], lg4[2], lb4[2];
#pragma unroll
            for (int n = 0; n < 2; ++n) { g4[n] = *(const f32x4*)(gate + c + 4 * n) * coef; lg4[n] = *(const f32x4*)(lg + c + 4 * n) * ALPHA; lb4[n] = *(const f32x4*)(lb + c + 4 * n) * ALPHA;
                if (first) { lg4[n] = (f32x4){ALPHA, ALPHA, ALPHA, ALPHA}; lb4[n] = (f32x4){0.f, 0.f, 0.f, 0.f}; } }
            {
                u32x4 rb[2][4];
#pragma unroll
                for (int ai = 0; ai < 2; ++ai)
#pragma unroll
                    for (int m = 0; m < 4; ++m) rb[ai][m] = *(const u32x4*)(yb + (size_t)(ai * 128 + wr * 64 + m * 16 + fr) * D + c);
#pragma unroll
                for (int ai = 0; ai < 2; ++ai)
#pragma unroll
                    for (int m = 0; m < 4; ++m) {
                        const u32x4 q = rb[ai][m]; f32x2 stv = stats[ai * 128 + wr * 64 + m * 16 + fr]; if (first) stv = (f32x2){0.f, 1.f}; const float mean = stv.x, rs = stv.y;
                        const f32x4 r0v = {bflo(q.x), bfhi(q.x), bflo(q.y), bfhi(q.y)}, r1v = {bflo(q.z), bfhi(q.z), bflo(q.w), bfhi(q.w)};
                        const f32x4 o0 = ((r0v - mean) * rs) * lg4[0] + lb4[0] + g4[0] * acc[ai][bj][m][0], o1 = ((r1v - mean) * rs) * lg4[1] + lb4[1] + g4[1] * acc[ai][bj][m][1];
                        const size_t off = (size_t)(ai * 128 + wr * 64 + m * 16 + fr) * D + c;
                        { u32x4 w; w.x = pk2(o0[0], o0[1]); w.y = pk2(o0[2], o0[3]); w.z = pk2(o1[0], o1[1]); w.w = pk2(o1[2], o1[3]); if (!dry) *(u32x4*)(yo + off) = w; }
                    }
                asm volatile("" ::: "memory");
            }
        }
    }
};
struct ProbMix {
    static constexpr bool PERM = true, KEEP = false;
    int K, lda; Order o; const bf16* A; const bf16* Bt; bf16* Pb; int half;
    DI bool next(int i, Unit& u) const { return o.tile((long)i * o.G + o.c, u); }
    DI const char* abase(const Unit& u) const { return (const char*)(A + (size_t)grow_of(u.pm, half) * lda); }
    DI const char* bbase(const Unit& u) const { return (const char*)(Bt + (size_t)u.pn * 256 * K); }
    DI void epi(Acc& acc, const Unit& u, int wr, int wc, int fr, int fq) const {
        const bool sg = u.pn >= 14;
#pragma unroll
        for (int ai = 0; ai < 2; ++ai)
#pragma unroll
            for (int m = 0; m < 4; ++m) {
                const int row = u.pm * 256 + ai * 128 + wr * 64 + m * 16 + fr;
#pragma unroll
                for (int bj = 0; bj < 2; ++bj) {
                    f32x4 v0 = acc[ai][bj][m][0], v1 = acc[ai][bj][m][1];
                    if (sg) {
#pragma unroll
                        for (int e = 0; e < 4; ++e) { v0[e] = sigm(v0[e]); v1[e] = sigm(v1[e]); }
                    }
                    u32x4 w; w.x = pk2(v0[0], v0[1]); w.y = pk2(v0[2], v0[3]); w.z = pk2(v1[0], v1[1]); w.w = pk2(v1[2], v1[3]);
                    *(u32x4*)(Pb + (size_t)row * NP + u.pn * 256 + bj * 128 + wc * 32 + 8 * fq) = w;
                }
            }
    }
};
struct ProbMerge {
    static constexpr bool PERM = true, KEEP = true;
    int K, lda; Order o; const bf16* Pb; const bf16* Wb; bf16* merged; int half;
    DI bool next(int i, Unit& u) const { const bool ok = o.tile((long)(i >> 2) * o.G + o.c, u); u.j = i & 3; return ok; }
    DI int acol(int j) const { return j == 0 ? C_NAQ : (j == 1 ? C_MLO : (j == 2 ? C_GLG : C_DAQ)); }
    DI const char* abase(const Unit& u) const { return (const char*)(Pb + (size_t)u.pm * 256 * lda + acol(u.j)); }
    DI const char* bbase(const Unit& u) const { return (const char*)(Wb + (size_t)u.j * 1024 * 256 + (size_t)u.pn * 256 * K); }
    DI void epi(Acc& acc, const Unit& u, int wr, int wc, int fr, int fq) const {
        const int j = u.j; const int grow0 = grow_of(u.pm, half);
        const bf16* gp0 = Pb + (size_t)(u.pm * 256 + wr * 64 + fr) * NP + C_GATE + j * 1024 + u.pn * 256 + wc * 32 + 8 * fq;
        const bool fin = (j == 3); const int nxt_off = fin ? 0 : 1024;
#pragma unroll
        for (int ai = 0; ai < 2; ++ai) {
            u32x4 ga[4][2], gb[4][2];
#pragma unroll
            for (int m = 0; m < 4; ++m)
#pragma unroll
                for (int bj = 0; bj < 2; ++bj) { const bf16* gp = gp0 + (size_t)(ai * 128 + m * 16) * NP + bj * 128; ga[m][bj] = *(const u32x4*)gp; gb[m][bj] = *(const u32x4*)(gp + nxt_off); }
#pragma unroll
            for (int m = 0; m < 4; ++m)
#pragma unroll
                for (int bj = 0; bj < 2; ++bj) {
                    const u32x4 a = ga[m][bj], b = gb[m][bj];
                    const float s[8] = {bflo(a.x), bfhi(a.x), bflo(a.y), bfhi(a.y), bflo(a.z), bfhi(a.z), bflo(a.w), bfhi(a.w)};
                    const float t[8] = {bflo(b.x), bfhi(b.x), bflo(b.y), bfhi(b.y), bflo(b.z), bfhi(b.z), bflo(b.w), bfhi(b.w)};
                    float o8[8];
#pragma unroll
                    for (int n = 0; n < 2; ++n)
#pragma unroll
                        for (int e = 0; e < 4; ++e) {
                            const float v = acc[ai][bj][m][n][e] * s[n * 4 + e];
                            o8[n * 4 + e] = v;
                            acc[ai][bj][m][n][e] = fin ? 0.f : v * __builtin_amdgcn_rcpf(fmaxf(t[n * 4 + e], 1e-30f));
                        }
                    if (fin) {
                        u32x4 w; w.x = pk2(o8[0], o8[1]); w.y = pk2(o8[2], o8[3]); w.z = pk2(o8[4], o8[5]); w.w = pk2(o8[6], o8[7]);
                        *(u32x4*)(merged + (size_t)(grow0 + ai * 128 + wr * 64 + m * 16 + fr) * D + u.pn * 256 + bj * 128 + wc * 32 + 8 * fq) = w;
                    }
                }
            asm volatile("" ::: "memory");
        }
    }
};
}

DI int map_ident(int n) { return n; }
DI int map_ffn(int n) { const int t = n >> 8, w = n & 255; return (w >> 7) * DFF + t * 128 + (w & 127); }
DI int map_mix(int n) {
    if (n < 1792) return n;
    if (n < 2560) return n + 16;
    if (n < 3328) return n + 48;
    if (n < 3344) return 1792 + (n - 3328);
    if (n < 3376) return 2576 + (n - 3344);
    if (n < 3584) return -1;
    return 3376 + (n - 3584);
}
template <int MAP>
DI void transpose_item(const float* W, int K, int Nsrc, bf16* WT, LAS float* scr, int kb, int nb, int lane) {
    const int k0 = 64 * kb, n0 = 32 * nb;
    const int nq = (lane & 7) * 4, kr = lane >> 3;
    const int nn = n0 + nq;
    const int sc = MAP == 0 ? map_ident(nn) : (MAP == 1 ? map_ffn(nn) : map_mix(nn));
    f32x4 v[8];
#pragma unroll
    for (int i = 0; i < 8; ++i) v[i] = sc >= 0 ? *(const f32x4*)(W + (size_t)(k0 + 8 * i + kr) * Nsrc + sc) : (f32x4){0.f, 0.f, 0.f, 0.f};
#pragma unroll
    for (int i = 0; i < 8; ++i) { LAS float* d = scr + (8 * i + kr) * 33 + nq; d[0] = v[i].x; d[1] = v[i].y; d[2] = v[i].z; d[3] = v[i].w; }
    LDS_WAIT();
    const int c = lane & 7;
#pragma unroll
    for (int j = 0; j < 4; ++j) { const int n = (lane >> 3) + 8 * j; const LAS float* s = scr + (8 * c) * 33 + n;
        u32x4 o; o.x = pk2(s[0 * 33], s[1 * 33]); o.y = pk2(s[2 * 33], s[3 * 33]); o.z = pk2(s[4 * 33], s[5 * 33]); o.w = pk2(s[6 * 33], s[7 * 33]);
        *(u32x4*)(WT + (size_t)(n0 + n) * K + k0 + 8 * c) = o; }
    LDS_WAIT();
}

DI void mods_item(PP p, LAS float* lds, int item) {
    const int l = item / 72, cbk = item % 72;
    const int tid = otid(), col = tid & 127, g = tid >> 7;
    LAS float* sc = lds; LAS float* red = lds + 33 * 128;
    float acc[33];
#pragma unroll
    for (int r = 0; r < 33; ++r) acc[r] = 0.f;
    const float* W = p->w_ada + (size_t)l * 1024 * 9216 + 128 * cbk + col;
    for (int kc = 0; kc < 8; ++kc) {
        __syncthreads();
        for (int e = tid; e < 33 * 128; e += 512) { const int r = e >> 7, kk = e & 127; const float v = r < 32 ? p->c[r * 1024 + kc * 128 + kk] : p->c_ctx[kc * 128 + kk]; sc[e] = v / (1.f + expf(-v)); }
        __syncthreads();
        for (int kk0 = 0; kk0 < 32; kk0 += 8) {
            float wv[8];
#pragma unroll
            for (int u = 0; u < 8; ++u) wv[u] = W[(size_t)(kc * 128 + g * 32 + kk0 + u) * 9216];
#pragma unroll
            for (int u = 0; u < 8; ++u) { const int k = g * 32 + kk0 + u;
#pragma unroll
                for (int r = 0; r < 33; ++r) acc[r] += sc[r * 128 + k] * wv[u]; }
        }
    }
#pragma unroll
    for (int r = 0; r < 33; ++r) red[(g * 33 + r) * 128 + col] = acc[r];
    __syncthreads();
    float* mods = (float*)(p->ws + WS_MODS);
    for (int e = tid; e < 33 * 128; e += 512) { const int r = e >> 7, cc = e & 127;
        const float v = red[(0 * 33 + r) * 128 + cc] + red[(1 * 33 + r) * 128 + cc] + red[(2 * 33 + r) * 128 + cc] + red[(3 * 33 + r) * 128 + cc];
        mods[(size_t)(l * 33 + r) * 9216 + 128 * cbk + cc] = v + p->b_ada[l * 9216 + 128 * cbk + cc]; }
    __syncthreads();
}

DI void p0_prologue(PP p, LAS unsigned char* lds) {
    for (int it = obid(); it < 144; it += ogrid()) mods_item(p, (LAS float*)lds, it);
    __syncthreads();
    const int wave = otid() >> 6, lane = otid() & 63;
    LAS float* scr = (LAS float*)(lds + wave * 8704);
    const int gw = obid() * 8 + wave, NGW = ogrid() * 8;
    constexpr int I_IN = 16 * 176, I_OUT = 44 * 32, I_MIX = 16 * 240, I_B = 4 * 32, I_O = 16 * 32;
    constexpr int NITEMS = 4 * I_IN + 4 * I_OUT + 2 * I_MIX + 8 * I_B + 2 * I_O;
    static_assert(NITEMS % 64 == 0, "chunking");
    unsigned* ctr = (unsigned*)(p->ws + WS_BAR) + 3600;
    volatile LAS int* slot = (volatile LAS int*)(lds + LDS_BYTES - 64 + 48);
    (void)gw; (void)NGW;
    for (;;) {
        __syncthreads();
        if (otid() == 0) *slot = (int)__hip_atomic_fetch_add(ctr, 1u, __ATOMIC_RELAXED, __HIP_MEMORY_SCOPE_AGENT);
        __syncthreads();
        const int chunk = *slot;
        if (chunk >= NITEMS / 64) break;
      for (int sub = 0; sub < 8; ++sub) {
        const int it = chunk * 64 + wave * 8 + sub;
        int r = it;
        if (r < 4 * I_IN) { const int w = r / I_IN, q = r % I_IN; transpose_item<1>(p->ffn_w_in + (size_t)w * 1024 * 5632, 1024, 5632, (bf16*)(p->ws + WS_WIN) + (size_t)w * 5632 * 1024, scr, q / 176, q % 176, lane); continue; } r -= 4 * I_IN;
        if (r < 4 * I_OUT) { const int w = r / I_OUT, q = r % I_OUT; transpose_item<0>(p->ffn_w_out + (size_t)w * DFF * 1024, DFF, 1024, (bf16*)(p->ws + WS_WOUTF) + (size_t)w * 1024 * DFF, scr, q / 32, q % 32, lane); continue; } r -= 4 * I_OUT;
        if (r < 2 * I_MIX) { const int w = r / I_MIX, q = r % I_MIX; transpose_item<2>(p->w_mix_in + (size_t)w * 1024 * 7472, 1024, 7472, (bf16*)(p->ws + WS_WMIX) + (size_t)w * NP * 1024, scr, q / 240, q % 240, lane); continue; } r -= 2 * I_MIX;
        if (r < 8 * I_B) { const int w = r / I_B, q = r % I_B; transpose_item<0>(p->w_branch + (size_t)w * 256 * 1024, 256, 1024, (bf16*)(p->ws + WS_WB) + (size_t)w * 1024 * 256, scr, q / 32, q % 32, lane); continue; } r -= 8 * I_B;
        { const int w = r / I_O, q = r % I_O; transpose_item<0>(p->w_out + (size_t)w * 1024 * 1024, 1024, 1024, (bf16*)(p->ws + WS_WO) + (size_t)w * 1024 * 1024, scr, q / 32, q % 32, lane); }
      }
    }
}

DI float wave_sum(float v) {
#pragma unroll
    for (int o = 1; o < 64; o <<= 1) v += __shfl_xor(v, o);
    return v;
}
DI void rows_phase(PP p, int mode, int nrows, int lnl, int lnw, bool hm, int ml, int ishift, int iscale, bool fin) {
    const int wave = otid() >> 6, lane = otid() & 63;
    const int gw = obid() * 8 + wave, NGW = ogrid() * 8;
    bf16* hmod = (bf16*)(p->ws + WS_HMOD);
    u32x2 pre[4][4];
#define ROWS_YPTR(r0_) ((fin ? (const u32x2*)((const bf16*)yfinrow(p, 0) + (size_t)(r0_) * D) : (const u32x2*)ybfrow(p, (r0_))) + lane)
    if (mode != 0 && gw < nrows / 4) { const u32x2* yr = ROWS_YPTR(gw * 4);
#pragma unroll
        for (int k = 0; k < 4; ++k)
#pragma unroll
            for (int j = 0; j < 4; ++j) pre[k][j] = yr[k * 256 + 64 * j]; }
    for (int gi = gw; gi < nrows / 4; gi += NGW) {
        const int r0 = gi * 4;
        f32x4 v[4][4];
        if (mode == 0) {
            const f32x4* xr = (const f32x4*)xrow(p, r0) + lane; u32x2* yw = (u32x2*)ybfrow(p, r0) + lane;
#pragma unroll
            for (int k = 0; k < 4; ++k)
#pragma unroll
                for (int j = 0; j < 4; ++j) { v[k][j] = xr[k * 256 + 64 * j]; u32x2 w; w.x = pk2(v[k][j].x, v[k][j].y); w.y = pk2(v[k][j].z, v[k][j].w); yw[k * 256 + 64 * j] = w; }
        } else {
            f32x4* lr = (f32x4*)latrow(p, r0) + lane; float s[4];
#pragma unroll
            for (int k = 0; k < 4; ++k)
#pragma unroll
                for (int j = 0; j < 4; ++j) { const u32x2 q = pre[k][j]; v[k][j] = (f32x4){bflo(q.x), bfhi(q.x), bflo(q.y), bfhi(q.y)}; }
            if (gi + NGW < nrows / 4) { const u32x2* yr = ROWS_YPTR((gi + NGW) * 4);
#pragma unroll
                for (int k = 0; k < 4; ++k)
#pragma unroll
                    for (int j = 0; j < 4; ++j) pre[k][j] = yr[k * 256 + 64 * j]; }
            float s2[4];
#pragma unroll
            for (int k = 0; k < 4; ++k) { s[k] = 0.f; s2[k] = 0.f;
#pragma unroll
                for (int j = 0; j < 4; ++j) { s[k] += (v[k][j].x + v[k][j].y) + (v[k][j].z + v[k][j].w); s2[k] += (v[k][j].x * v[k][j].x + v[k][j].y * v[k][j].y) + (v[k][j].z * v[k][j].z + v[k][j].w * v[k][j].w); } }
#pragma unroll
            for (int o = 1; o < 64; o <<= 1) {
#pragma unroll
                for (int k = 0; k < 4; ++k) { s[k] += __shfl_xor(s[k], o); s2[k] += __shfl_xor(s2[k], o); } }
#pragma unroll
            for (int k = 0; k < 4; ++k) { const float mean = s[k] * (1.f / D); s2[k] = fmaxf(s2[k] * (1.f / D) - mean * mean, 0.f) * D;
#pragma unroll
                for (int j = 0; j < 4; ++j) v[k][j] = v[k][j] - mean; }
            const f32x4* gg = (const f32x4*)(p->ln_g + (size_t)(lnl * 3 + lnw) * D) + lane; const f32x4* bb = (const f32x4*)(p->ln_b + (size_t)(lnl * 3 + lnw) * D) + lane;
            float rstd[4];
#pragma unroll
            for (int k = 0; k < 4; ++k) rstd[k] = __builtin_amdgcn_rsqf(s2[k] * (1.f / D) + 1e-5f);
            if (!fin && lane < 4) { f32x2* stats = (f32x2*)(p->ws) + r0; const float mk = lane == 0 ? s[0] : (lane == 1 ? s[1] : (lane == 2 ? s[2] : s[3])), rk = lane == 0 ? rstd[0] : (lane == 1 ? rstd[1] : (lane == 2 ? rstd[2] : rstd[3]));
                stats[lane] = (f32x2){mk * (1.f / D), rk}; }
#pragma unroll
            for (int j = 0; j < 4; ++j) { const f32x4 g4 = gg[64 * j], b4 = bb[64 * j];
#pragma unroll
                for (int k = 0; k < 4; ++k) { v[k][j] = v[k][j] * rstd[k] * g4 + b4; if (fin) lr[k * 256 + 64 * j] = v[k][j]; } }
        }
        if (hm) {
            const float* mr = modrow(p, ml, r0);
            const f32x4* sh = (const f32x4*)(mr + ishift * D) + lane; const f32x4* sc = (const f32x4*)(mr + iscale * D) + lane;
            u32x2* o8 = (u32x2*)(hmod + (size_t)r0 * D) + lane;
#pragma unroll
            for (int j = 0; j < 4; ++j) { const f32x4 sc4 = sc[64 * j] + 1.f, sh4 = sh[64 * j];
#pragma unroll
                for (int k = 0; k < 4; ++k) { const f32x4 h = v[k][j] * sc4 + sh4; u32x2 w; w.x = pk2(h.x, h.y); w.y = pk2(h.z, h.w); o8[k * 256 + 64 * j] = w; } }
        }
    }
}

#undef ROWS_YPTR
DI bf16x8 ld8(const bf16* p) { return *(const bf16x8*)p; }
DI bf16x8 cat4(s16x4 a, s16x4 b) { return __builtin_shufflevector(a, b, 0, 1, 2, 3, 4, 5, 6, 7); }
DI int perm64(int r) { return r < 64 ? 8 * (r & 7) + (r >> 3) : r; }
template <int PA = 0, int PB = 0>
DI f32x4 mm16(const LAS bf16* A, int lda, int m0, const LAS bf16* B, int ldb, int n0, int K, f32x4 acc, int ql, int g) {
    const int ra = PA ? perm64(m0 + ql) : m0 + ql, rb = PB ? perm64(n0 + ql) : n0 + ql;
#pragma unroll
    for (int k0 = 0; k0 < K; k0 += 32) {
        const bf16x8 a = *(const LAS bf16x8*)(A + ra * lda + k0 + 8 * g);
        const bf16x8 b = *(const LAS bf16x8*)(B + rb * ldb + k0 + 8 * g);
        acc = MFMA16(a, b, acc);
    }
    return acc;
}

DI void da_item(PP p, bf16* Pb, LAS unsigned char* lds, int l, bool ctxq, int bl, int h, int qb, float lam, float lam_init, bool wr) {
    LAS float* tab = (LAS float*)(lds + 38912); LAS float* red = (LAS float*)(lds + 43008);
    const int tid = otid(), wave = tid >> 6, lane = tid & 63, g = lane >> 4, ql = lane & 15;
    const int latbase = bl * 2048, ctxbase = 32768 + bl * 256;
    const int ntiles = ctxq ? 4 : 36;
    __syncthreads();
    { const int pos = tid >> 3, i = tid & 7; const float inv = exp2f(-(float)i * (13.287712379549449f / 8.f)); float s, c; sincosf((float)pos * inv, &s, &c); tab[tid * 2] = c; tab[tid * 2 + 1] = s; }
    {
        float m1 = 0.f, m2 = 0.f;
        for (int kk = tid; kk < ntiles * 64; kk += 512) {
            const int row = (!ctxq && kk < 2048) ? latbase + kk : ctxbase + (ctxq ? kk : kk - 2048);
            const bf16* kp = Pb + (size_t)row * NP + C_DAK + 64 * h;
            float n1 = 0.f, n2 = 0.f;
#pragma unroll
            for (int c4 = 0; c4 < 4; ++c4) { const bf16x8 a = ld8(kp + 8 * c4), b2 = ld8(kp + 32 + 8 * c4);
#pragma unroll
                for (int e = 0; e < 8; ++e) { const float x = bf2f((unsigned short)a[e]), y = bf2f((unsigned short)b2[e]); n1 += x * x; n2 += y * y; } }
            m1 = fmaxf(m1, n1); m2 = fmaxf(m2, n2);
        }
#pragma unroll
        for (int o = 1; o < 64; o <<= 1) { m1 = fmaxf(m1, __shfl_xor(m1, o)); m2 = fmaxf(m2, __shfl_xor(m2, o)); }
        if (lane == 0) { red[wave * 2] = m1; red[wave * 2 + 1] = m2; }
    }
    __syncthreads();
    float kmax[2];
    { float m1 = 0.f, m2 = 0.f;
#pragma unroll
        for (int w = 0; w < 8; ++w) { m1 = fmaxf(m1, red[w * 2]); m2 = fmaxf(m2, red[w * 2 + 1]); }
        kmax[0] = sqrtf(m1) * 1.01f; kmax[1] = sqrtf(m2) * 1.01f; }
    const float qscale = 0.17677669529663687f * LOG2E;
    bf16x8 qf[2][2]; float mref[2][2];
#pragma unroll
    for (int mp = 0; mp < 2; ++mp)
#pragma unroll
        for (int qg = 0; qg < 2; ++qg) {
            const int tq = (ctxq ? 0 : qb * 256) + wave * 32 + qg * 16 + ql;
            const bf16* qp = Pb + (size_t)((ctxq ? ctxbase : latbase) + tq) * NP + C_DAQ + 64 * h + 32 * mp;
            const bf16x8 own = ld8(qp + 8 * g), oth = ld8(qp + 8 * (g ^ 1));
            float o[8];
            if (ctxq) {
#pragma unroll
                for (int e = 0; e < 8; ++e) o[e] = bf2f((unsigned short)own[e]);
            } else {
                const int pos = (g < 2) ? (tq >> 6) : (tq & 63);
#pragma unroll
                for (int e = 0; e < 8; ++e) { const float c = tab[(pos * 8 + e) * 2], sn = tab[(pos * 8 + e) * 2 + 1]; const float a = bf2f((unsigned short)own[e]), b2 = bf2f((unsigned short)oth[e]);
                    o[e] = (g & 1) ? (b2 * sn + a * c) : (a * c - b2 * sn); }
            }
            float nn = 0.f;
#pragma unroll
            for (int e = 0; e < 8; ++e) { o[e] *= qscale; nn += o[e] * o[e]; }
            nn += __shfl_xor(nn, 16); nn += __shfl_xor(nn, 32);
            mref[mp][qg] = sqrtf(nn) * 1.01f * kmax[mp];
            u32x4 w; w.x = pk2(o[0], o[1]); w.y = pk2(o[2], o[3]); w.z = pk2(o[4], o[5]); w.w = pk2(o[6], o[7]);
            qf[mp][qg] = __builtin_bit_cast(bf16x8, w);
        }
    f32x4 O[2][2][4]; float lsum[2][2];
#pragma unroll
    for (int a = 0; a < 2; ++a)
#pragma unroll
        for (int b2 = 0; b2 < 2; ++b2) { lsum[a][b2] = 0.f;
#pragma unroll
            for (int k = 0; k < 4; ++k) O[a][b2][k] = (f32x4){0.f, 0.f, 0.f, 0.f}; }
    const int skey = tid >> 3, smp = (tid >> 2) & 1, ssec = (tid >> 1) & 1, shf = tid & 1, vseg = tid & 7;
    bf16x8 pre0, pre1, pre2;
#define DA_PREFETCH(kt_) do { const int kt__ = (kt_); const bool lk = !ctxq && kt__ < 32; const int kr0 = lk ? latbase + kt__ * 64 : ctxbase + (ctxq ? kt__ : kt__ - 32) * 64; \
        const bf16* rp = Pb + (size_t)(kr0 + skey) * NP + 64 * h; const bf16* kp = rp + C_DAK + 32 * smp + 16 * ssec; pre0 = ld8(kp); pre1 = ld8(kp + 8); pre2 = ld8(rp + C_DAV + 8 * vseg); } while (0)
#define DA_STAGE(kt_) do { const int kt__ = (kt_); const bool lk = !ctxq && kt__ < 32; LAS unsigned char* bb = lds + (kt__ & 1) * 19456; \
        LAS bf16* dst = (LAS bf16*)(bb + smp * 5120) + skey * 40 + 16 * ssec + 8 * shf; \
        if (lk) { const int pos = ssec == 0 ? kt__ : skey; float o[8]; \
            _Pragma("unroll") for (int e = 0; e < 8; ++e) { const float c = tab[(pos * 8 + e) * 2], sn = tab[(pos * 8 + e) * 2 + 1]; const float a = bf2f((unsigned short)pre0[e]), b2 = bf2f((unsigned short)pre1[e]); o[e] = shf ? (a * sn + b2 * c) : (a * c - b2 * sn); } \
            u32x4 w1; w1.x = pk2(o[0], o[1]); w1.y = pk2(o[2], o[3]); w1.z = pk2(o[4], o[5]); w1.w = pk2(o[6], o[7]); *(LAS u32x4*)dst = w1; \
        } else { *(LAS bf16x8*)dst = shf ? pre1 : pre0; } \
        LAS bf16* Vw = (LAS bf16*)(bb + 10240); \
        _Pragma("unroll") for (int e = 0; e < 8; ++e) Vw[(8 * e + vseg) * 72 + skey] = (bf16)pre2[e]; } while (0)
    DA_PREFETCH(0);
    DA_STAGE(0);
    if (ntiles > 1) DA_PREFETCH(1);
    __syncthreads();
    for (int kt = 0; kt < ntiles; ++kt) {
        if (kt + 1 < ntiles) DA_STAGE(kt + 1);
        if (kt + 2 < ntiles) DA_PREFETCH(kt + 2);
        LAS unsigned char* bb = lds + (kt & 1) * 19456;
        const LAS bf16* K1s = (const LAS bf16*)bb; const LAS bf16* K2s = (const LAS bf16*)(bb + 5120); const LAS bf16* Vt = (const LAS bf16*)(bb + 10240);
#pragma unroll
        for (int st = 0; st < 2; ++st) {
            bf16x8 vf[4];
#pragma unroll
            for (int blk = 0; blk < 4; ++blk) { const LAS bf16* vp = Vt + (8 * (ql & 7) + 2 * blk + (ql >> 3)) * 72 + 32 * st + 4 * g; vf[blk] = cat4(*(const LAS s16x4*)vp, *(const LAS s16x4*)(vp + 16)); }
#pragma unroll
            for (int mp = 0; mp < 2; ++mp) {
                const LAS bf16* Ks = mp ? K2s : K1s;
                const bf16x8 ka = *(const LAS bf16x8*)(Ks + (32 * st + ql) * 40 + 8 * g), kb = *(const LAS bf16x8*)(Ks + (32 * st + 16 + ql) * 40 + 8 * g);
#pragma unroll
                for (int qg = 0; qg < 2; ++qg) {
                    const float mr = mref[mp][qg];
                    const f32x4 z = {-mr, -mr, -mr, -mr};
                    const f32x4 s0 = MFMA16(ka, qf[mp][qg], z), s1 = MFMA16(kb, qf[mp][qg], z);
                    float pv[8]; float ps = 0.f;
#pragma unroll
                    for (int e = 0; e < 4; ++e) { pv[e] = __builtin_amdgcn_exp2f(s0[e]); pv[4 + e] = __builtin_amdgcn_exp2f(s1[e]); ps += pv[e] + pv[4 + e]; }
                    lsum[mp][qg] += ps;
                    u32x4 w; w.x = pk2(pv[0], pv[1]); w.y = pk2(pv[2], pv[3]); w.z = pk2(pv[4], pv[5]); w.w = pk2(pv[6], pv[7]);
                    const bf16x8 pt = __builtin_bit_cast(bf16x8, w);
#pragma unroll
                    for (int blk = 0; blk < 4; ++blk) O[mp][qg][blk] = MFMA16(vf[blk], pt, O[mp][qg][blk]);
                }
            }
        }
        __syncthreads();
    }
#undef DA_STAGE
#undef DA_PREFETCH
    const float* ng = p->da_norm_g + l * 256 + 64 * h;
#pragma unroll
    for (int qg = 0; qg < 2; ++qg) {
        float l1 = lsum[0][qg]; l1 += __shfl_xor(l1, 16); l1 += __shfl_xor(l1, 32);
        float l2 = lsum[1][qg]; l2 += __shfl_xor(l2, 16); l2 += __shfl_xor(l2, 32);
        const float i1 = 1.f / l1, i2 = lam / l2;
        f32x4 o[4]; float ss = 0.f;
#pragma unroll
        for (int blk = 0; blk < 4; ++blk) { o[blk] = O[0][qg][blk] * i1 - O[1][qg][blk] * i2; ss += o[blk][0] * o[blk][0] + o[blk][1] * o[blk][1] + o[blk][2] * o[blk][2] + o[blk][3] * o[blk][3]; }
        ss += __shfl_xor(ss, 16); ss += __shfl_xor(ss, 32);
        const float rn = (1.f - lam_init) / sqrtf(ss * (1.f / 64.f) + 1e-6f);
        const int tq = (ctxq ? 0 : qb * 256) + wave * 32 + qg * 16 + ql;
        bf16* op = Pb + (size_t)((ctxq ? ctxbase : latbase) + tq) * NP + C_DAQ + 64 * h;
#pragma unroll
        for (int blk = 0; blk < 4; ++blk) { const f32x4 gg = *(const f32x4*)(ng + 16 * blk + 4 * g); const f32x4 y = o[blk] * rn * gg; u32x2 w; w.x = pk2(y[0], y[1]); w.y = pk2(y[2], y[3]); if (wr) *(u32x2*)(op + 16 * blk + 4 * g) = w; }
    }
}

DI void na_wave(PP p, bf16* Pb, const LAS float* bias, LAS bf16* Vt, bool ctxq, int bl, int h, int r, int cb, int cq0, bool wr) {
    const int lane = otid() & 63, g = lane >> 4, ql = lane & 15;
    const int latbase = bl * 2048, ctxbase = 32768 + bl * 256;
    const int cq = 16 * cb + ql;
    const int rowq = ctxq ? ctxbase + cq0 + ql : latbase + 64 * r + cq;
    const int r0 = min(max(r - 4, 0), 24), cs = cb == 0 ? 0 : (cb == 1 ? 8 : (cb == 2 ? 24 : 32)), c0 = min(max(cq - 8, 0), 48);
    bf16x8 qf[2];
    qf[0] = ld8(Pb + (size_t)rowq * NP + C_NAQ + 64 * h + 8 * g); qf[1] = ld8(Pb + (size_t)rowq * NP + C_NAQ + 64 * h + 32 + 8 * g);
    f32x4 O[4]; float mrun = -INFINITY, lsum = 0.f;
#pragma unroll
    for (int k = 0; k < 4; ++k) O[k] = (f32x4){0.f, 0.f, 0.f, 0.f};
    const int nsteps = ctxq ? 8 : 16;
    bf16x8 kfa[2][2], vpa[4], kfb[2][2], vpb[4];
#define NA_LOAD(st_, KF, VP) do { const int st__ = (st_); const bool loc__ = !ctxq && st__ < 8; const int kb__ = loc__ ? latbase + 64 * (r0 + st__) + cs : ctxbase + 32 * (ctxq ? st__ : st__ - 8); \
        _Pragma("unroll") for (int i = 0; i < 4; ++i) { const int piece = lane + 64 * i; VP[i] = ld8(Pb + (size_t)(kb__ + (piece >> 3)) * NP + C_NAV + 64 * h + 8 * (piece & 7)); } \
        _Pragma("unroll") for (int kt = 0; kt < 2; ++kt) { const bf16* kp = Pb + (size_t)(kb__ + 16 * kt + ql) * NP + C_NAK + 64 * h + 8 * g; KF[kt][0] = ld8(kp); KF[kt][1] = ld8(kp + 32); } } while (0)
#define NA_STEP(st_, KF, VP) do { const int st = (st_); const bool local = !ctxq && st < 8; \
        LDS_WAIT(); \
        _Pragma("unroll") for (int i = 0; i < 4; ++i) { const int piece = lane + 64 * i, key = piece >> 3, seg = piece & 7; \
            _Pragma("unroll") for (int e = 0; e < 8; ++e) Vt[(8 * e + seg) * 36 + key] = (bf16)VP[i][e]; } \
        f32x4 s[2]; \
        _Pragma("unroll") for (int kt = 0; kt < 2; ++kt) { const f32x4 z = {0.f, 0.f, 0.f, 0.f}; s[kt] = MFMA16(KF[kt][0], qf[0], z); s[kt] = MFMA16(KF[kt][1], qf[1], s[kt]); } \
        float mx = -INFINITY; \
        _Pragma("unroll") for (int kt = 0; kt < 2; ++kt) \
            _Pragma("unroll") for (int j = 0; j < 4; ++j) { \
                float v = s[kt][j] * (0.125f * LOG2E); \
                if (local) { const int col = cs + 16 * kt + 4 * g + j; const bool ok = col >= c0 && col < c0 + 16; \
                    const int bi = (r0 + st - r + 7) * 31 + min(max(col - cq + 15, 0), 30); \
                    v = ok ? v + bias[bi] : -INFINITY; } \
                s[kt][j] = v; mx = fmaxf(mx, v); } \
        mx = fmaxf(mx, __shfl_xor(mx, 16)); mx = fmaxf(mx, __shfl_xor(mx, 32)); \
        const float mnew = fmaxf(mrun, mx), alpha = __builtin_amdgcn_exp2f(mrun - mnew); mrun = mnew; \
        float pv[8]; float ps = 0.f; \
        _Pragma("unroll") for (int e = 0; e < 4; ++e) { pv[e] = __builtin_amdgcn_exp2f(s[0][e] - mnew); pv[4 + e] = __builtin_amdgcn_exp2f(s[1][e] - mnew); ps += pv[e] + pv[4 + e]; } \
        lsum = lsum * alpha + ps; \
        u32x4 w; w.x = pk2(pv[0], pv[1]); w.y = pk2(pv[2], pv[3]); w.z = pk2(pv[4], pv[5]); w.w = pk2(pv[6], pv[7]); \
        const bf16x8 pt = __builtin_bit_cast(bf16x8, w); \
        LDS_WAIT(); \
        _Pragma("unroll") for (int blk = 0; blk < 4; ++blk) { const LAS bf16* vp = Vt + (8 * (ql & 7) + 2 * blk + (ql >> 3)) * 36 + 4 * g; const bf16x8 vf = cat4(*(const LAS s16x4*)vp, *(const LAS s16x4*)(vp + 16)); \
            O[blk] = O[blk] * alpha; O[blk] = MFMA16(vf, pt, O[blk]); } } while (0)
    NA_LOAD(0, kfa, vpa);
    for (int st2 = 0; st2 < nsteps; st2 += 2) {
        NA_LOAD(st2 + 1, kfb, vpb);
        NA_STEP(st2, kfa, vpa);
        if (st2 + 2 < nsteps) NA_LOAD(st2 + 2, kfa, vpa);
        NA_STEP(st2 + 1, kfb, vpb);
    }
#undef NA_LOAD
#undef NA_STEP
    float lt = lsum; lt += __shfl_xor(lt, 16); lt += __shfl_xor(lt, 32);
    const float il = 1.f / lt;
    bf16* op = Pb + (size_t)rowq * NP + C_NAQ + 64 * h;
#pragma unroll
    for (int blk = 0; blk < 4; ++blk) { const f32x4 y = O[blk] * il; u32x2 w; w.x = pk2(y[0], y[1]); w.y = pk2(y[2], y[3]); if (wr) *(u32x2*)(op + 16 * blk + 4 * g) = w; }
}

DI int scan_row(int n, int dir, int latbase, int ctxbase) { const bool isc = n < 256; const int pos = isc ? n : n - 256; return (isc ? ctxbase : latbase) + (dir ? (isc ? 255 : 2047) - pos : pos); }
DI void mlstm_task(PP p, bf16* Pb, float* hbuf, LAS unsigned char* lds, int l, int bl, int h, int dir) {
    LAS bf16* Qs = (LAS bf16*)lds; LAS bf16* Ks = (LAS bf16*)(lds + 9216); LAS bf16* Vt = (LAS bf16*)(lds + 18432); LAS bf16* SW = (LAS bf16*)(lds + 29952);
    LAS bf16* Kt = (LAS bf16*)(lds + 39168); LAS bf16* Cb = (LAS bf16*)(lds + 48384); LAS float* Ct = (LAS float*)(lds + 59904); LAS float* NUM = (LAS float*)(lds + 80384);
    LAS float* tb = (LAS float*)(lds + 101120); LAS float* tib = tb + 2304; LAS float* tmt = tib + 2304; LAS float* csc = tmt + 2304;
    const int tid = otid(), wave = tid >> 6, lane = tid & 63, g = lane >> 4, ql = lane & 15;
    const int latbase = bl * 2048, ctxbase = 32768 + bl * 256;
    bf16* hout = (bf16*)hbuf + (size_t)dir * HROWS * 256;
    const int t = tid >> 3, seg = tid & 7;
    __syncthreads();
    for (int e = tid; e < 80 * 64; e += 512) Ct[e] = 0.f;
    for (int e = tid; e < 80 * 72; e += 512) Cb[e] = 0;
    for (int e = tid; e < 16 * 72; e += 512) Vt[64 * 72 + e] = (e < 64) ? (bf16)0x3F80 : (bf16)0;
    {
        const float gbi = p->ml_gate_b[l * 16 + (dir ? 8 : 0) + h], gbf = p->ml_gate_b[l * 16 + (dir ? 12 : 4) + h];
        for (int n = tid; n < 2304; n += 512) { const bf16* gp = Pb + (size_t)scan_row(n, dir, latbase, ctxbase) * NP + C_MLIF;
            tib[n] = bf2f(gp[(dir ? 8 : 0) + h]) + gbi; tb[n] = logsig(bf2f(gp[(dir ? 12 : 4) + h]) + gbf); }
    }
    __syncthreads();
    for (int c = wave; c < 36; c += 8) {
        const int n = 64 * c + lane; const float ib = tib[n]; float b = tb[n];
#pragma unroll
        for (int o = 1; o < 64; o <<= 1) { const float x = __shfl_up(b, o); if (lane >= o) b += x; }
        float pm = ib - b;
#pragma unroll
        for (int o = 1; o < 64; o <<= 1) { const float x = __shfl_up(pm, o); if (lane >= o) pm = fmaxf(pm, x); }
        const float bend = __shfl(b, 63); float km = bend - b + ib;
#pragma unroll
        for (int o = 1; o < 64; o <<= 1) km = fmaxf(km, __shfl_xor(km, o));
        tb[n] = b; tmt[n] = pm; if (lane == 0) { csc[4 * c] = bend; csc[4 * c + 1] = km; }
    }
    __syncthreads();
    if (tid == 0) { float mprev = 0.f; for (int c = 0; c < 36; ++c) { const float mnew = fmaxf(csc[4 * c] + mprev, csc[4 * c + 1]); csc[4 * c + 2] = mprev; csc[4 * c + 3] = mnew; mprev = mnew; } }
    __syncthreads();
    for (int n = tid; n < 2304; n += 512) { const float b = tb[n]; tmt[n] = fmaxf(b + csc[4 * (n >> 6) + 2], b + tmt[n]); }
    bf16x8 pq, pk, pv;
#define ML_PREF(c_) do { const bf16* rp = Pb + (size_t)scan_row(64 * (c_) + t, dir, latbase, ctxbase) * NP + 64 * h + 8 * seg; pq = ld8(rp + C_MLQ); pk = ld8(rp + C_MLK); pv = ld8(rp + C_MLV); } while (0)
#define ML_OUT(c_) do { const int n_ = 64 * (c_) + t; const float den = fmaxf(fabsf(NUM[t * 81 + 64]), __expf(-tmt[n_])); const float id = __builtin_amdgcn_rcpf(den); \
        bf16* op = hout + (size_t)scan_row(n_, dir, latbase, ctxbase) * 256 + 64 * h + 8 * seg; f32x4 o0, o1; \
        _Pragma("unroll") for (int e = 0; e < 4; ++e) { o0[e] = NUM[t * 81 + 8 * seg + e] * id; o1[e] = NUM[t * 81 + 8 * seg + 4 + e] * id; } \
        u32x4 w_; w_.x = pk2(o0[0], o0[1]); w_.y = pk2(o0[2], o0[3]); w_.z = pk2(o1[0], o1[1]); w_.w = pk2(o1[2], o1[3]); *(u32x4*)op = w_; } while (0)
    ML_PREF(0);
    for (int c = 0; c < 36; ++c) {
        if (c > 0) { ML_OUT(c - 1); for (int e = tid; e < 80 * 64; e += 512) Cb[(e >> 6) * 72 + (e & 63)] = (bf16)f2bf(Ct[e]); }
        {
            const int n = 64 * c + t; const float wk = __expf(csc[4 * c] - tb[n] + tib[n] - csc[4 * c + 3]);
            float qv[8], kv[8];
#pragma unroll
            for (int e = 0; e < 8; ++e) { qv[e] = bf2f((unsigned short)pq[e]) * 0.125f; kv[e] = bf2f((unsigned short)pk[e]) * wk; }
            u32x4 w; w.x = pk2(qv[0], qv[1]); w.y = pk2(qv[2], qv[3]); w.z = pk2(qv[4], qv[5]); w.w = pk2(qv[6], qv[7]);
            *(LAS u32x4*)(Qs + t * 72 + 8 * seg) = w; *(LAS bf16x8*)(Ks + t * 72 + 8 * seg) = pk;
#pragma unroll
            for (int e = 0; e < 8; ++e) { Vt[(8 * e + seg) * 72 + t] = (bf16)pv[e]; Kt[(8 * e + seg) * 72 + t] = (bf16)f2bf(kv[e]); }
        }
        __syncthreads();
        if (c + 1 < 36) ML_PREF(c + 1);
#pragma unroll
        for (int it = 0; it < 2; ++it) {
            const int tile = wave + 8 * it;
            const int tm = tile >> 2, ts = tile & 3; f32x4 a = {0.f, 0.f, 0.f, 0.f};
            a = mm16(Qs, 72, 16 * tm, Ks, 72, 16 * ts, 64, a, ql, g);
            const int sI = 16 * ts + ql; const float cs = tib[64 * c + sI] - tb[64 * c + sI];
#pragma unroll
            for (int j = 0; j < 4; ++j) { const int tt = 16 * tm + 4 * g + j; const float w = (sI <= tt) ? __expf(tb[64 * c + tt] - tmt[64 * c + tt] + cs) : 0.f; SW[tt * 72 + sI] = (bf16)f2bf(a[j] * w); }
        }
        __syncthreads();
#pragma unroll
        for (int it = 0; it < 3; ++it) {
            const int tile0 = wave + 8 * it; const bool valid = tile0 < 20; const int tile = valid ? tile0 : 19;
            const int tm = tile / 5, tv = tile % 5; f32x4 a1 = {0.f, 0.f, 0.f, 0.f}, a2 = {0.f, 0.f, 0.f, 0.f};
            a1 = mm16<0, 1>(SW, 72, 16 * tm, Vt, 72, 16 * tv, 64, a1, ql, g);
            a2 = mm16(Qs, 72, 16 * tm, Cb, 72, 16 * tv, 64, a2, ql, g);
#pragma unroll
            for (int j = 0; j < 4; ++j) { const int tt = 16 * tm + 4 * g + j; const float wi = __expf(tb[64 * c + tt] + csc[4 * c + 2] - tmt[64 * c + tt]); NUM[tt * 81 + 16 * tv + ql] = a1[j] + wi * a2[j]; }
        }
        {
            const float decay = __expf(csc[4 * c] + csc[4 * c + 2] - csc[4 * c + 3]);
#pragma unroll
            for (int it = 0; it < 3; ++it) {
                const int tile0 = wave + 8 * it; const bool valid = tile0 < 20; const int tile = valid ? tile0 : 19;
                const int tv = tile >> 2, td = tile & 3; f32x4 a = {0.f, 0.f, 0.f, 0.f};
                a = mm16<1, 1>(Vt, 72, 16 * tv, Kt, 72, 16 * td, 64, a, ql, g);
#pragma unroll
                for (int j = 0; j < 4; ++j) { const int idx = (16 * tv + 4 * g + j) * 64 + 16 * td + ql; const float nv = decay * Ct[idx] + a[j]; if (valid) Ct[idx] = nv; }
            }
        }
        __syncthreads();
    }
    ML_OUT(35);
#undef ML_PREF
#undef ML_OUT
}

DI void gla_task(PP p, bf16* Pb, float* hbuf, LAS unsigned char* lds, int l, int bl, int h, int dir) {
    LAS bf16* Qg = (LAS bf16*)lds; LAS bf16* Kg = (LAS bf16*)(lds + 5120); LAS bf16* Vt = (LAS bf16*)(lds + 10240); LAS bf16* ATT = (LAS bf16*)(lds + 19456);
    LAS bf16* Kt = (LAS bf16*)(lds + 28672); LAS bf16* Sb = (LAS bf16*)(lds + 33280); LAS float* St = (LAS float*)(lds + 38400);
    LAS float* Wa = (LAS float*)(lds + 46592); LAS float* ba = (LAS float*)(lds + 48640); LAS float* decv = (LAS float*)(lds + 48768);
    const int tid = otid(), wave = tid >> 6, lane = tid & 63, g = lane >> 4, ql = lane & 15;
    const int latbase = bl * 2048, ctxbase = 32768 + bl * 256;
    bf16* hout = (bf16*)hbuf + (size_t)(2 + dir) * HROWS * 256;
    __syncthreads();
    for (int e = tid; e < 64 * 32; e += 512) St[e] = 0.f;
    for (int e = tid; e < 64 * 40; e += 512) Sb[e] = 0;
    { const int r = tid >> 5, d = tid & 31; Wa[tid] = p->gla_w_a2[(size_t)((l * 2 + dir) * 16 + r) * 128 + 32 * h + d]; if (tid < 32) ba[tid] = p->gla_b_a[(l * 2 + dir) * 128 + 32 * h + tid]; }
    __syncthreads();
    float wa[16][4], bav[4];
#pragma unroll
    for (int r = 0; r < 16; ++r)
#pragma unroll
        for (int e = 0; e < 4; ++e) wa[r][e] = Wa[r * 32 + 4 * wave + e];
#pragma unroll
    for (int e = 0; e < 4; ++e) bav[e] = ba[4 * wave + e];
    const float qs = 0.17677669529663687f;
    bf16x8 pa0, pa1, pvv; u32x2 pq, pk;
#define GL_PREF(c_) do { const bf16* rp = Pb + (size_t)scan_row(64 * (c_) + lane, dir, latbase, ctxbase) * NP; \
        pa0 = ld8(rp + C_GLA + 16 * dir); pa1 = ld8(rp + C_GLA + 16 * dir + 8); pq = *(const u32x2*)(rp + C_GLQ + 32 * h + 4 * wave); pk = *(const u32x2*)(rp + C_GLK + 32 * h + 4 * wave); \
        pvv = ld8(Pb + (size_t)scan_row(64 * (c_) + (tid >> 3), dir, latbase, ctxbase) * NP + C_GLV + 64 * h + 8 * (tid & 7)); } while (0)
    GL_PREF(0);
    for (int c = 0; c < 36; ++c) {
        if (c > 0) { for (int e = tid; e < 64 * 32; e += 512) Sb[(e >> 5) * 40 + (e & 31)] = (bf16)f2bf(St[e]); }
        {
            float av[16];
#pragma unroll
            for (int e = 0; e < 8; ++e) { av[e] = bf2f((unsigned short)pa0[e]); av[8 + e] = bf2f((unsigned short)pa1[e]); }
            float bb[4];
#pragma unroll
            for (int e = 0; e < 4; ++e) { float z = bav[e];
#pragma unroll
                for (int r = 0; r < 16; ++r) z += av[r] * wa[r][e];
                bb[e] = logsig_fast(z) * (1.f / 16.f); }
#pragma unroll
            for (int o = 1; o < 64; o <<= 1) {
#pragma unroll
                for (int e = 0; e < 4; ++e) { const float x = __shfl_up(bb[e], o); if (lane >= o) bb[e] += x; } }
            const float qv[4] = {bflo(pq.x), bfhi(pq.x), bflo(pq.y), bfhi(pq.y)}, kv[4] = {bflo(pk.x), bfhi(pk.x), bflo(pk.y), bfhi(pk.y)};
            float qo[4], ko[4];
#pragma unroll
            for (int e = 0; e < 4; ++e) { const float be = __shfl(bb[e], 63); qo[e] = qv[e] * qs * __expf(bb[e]); ko[e] = kv[e] * __expf(-bb[e]);
                Kt[(4 * wave + e) * 72 + lane] = (bf16)f2bf(kv[e] * __expf(be - bb[e])); if (lane == 0) decv[4 * wave + e] = __expf(be); }
            u32x2 w; w.x = pk2(qo[0], qo[1]); w.y = pk2(qo[2], qo[3]); *(LAS u32x2*)(Qg + lane * 40 + 4 * wave) = w;
            w.x = pk2(ko[0], ko[1]); w.y = pk2(ko[2], ko[3]); *(LAS u32x2*)(Kg + lane * 40 + 4 * wave) = w;
            const int tt = tid >> 3, seg = tid & 7;
#pragma unroll
            for (int e = 0; e < 8; ++e) Vt[(8 * e + seg) * 72 + tt] = (bf16)pvv[e];
        }
        __syncthreads();
        if (c + 1 < 36) GL_PREF(c + 1);
#pragma unroll
        for (int it = 0; it < 2; ++it) {
            const int tile = wave + 8 * it;
            const int tm = tile >> 2, ts = tile & 3; f32x4 a = {0.f, 0.f, 0.f, 0.f};
            a = mm16(Qg, 40, 16 * tm, Kg, 40, 16 * ts, 32, a, ql, g);
            const int sI = 16 * ts + ql;
#pragma unroll
            for (int j = 0; j < 4; ++j) { const int tt = 16 * tm + 4 * g + j; ATT[tt * 72 + sI] = (bf16)f2bf(sI <= tt ? a[j] : 0.f); }
        }
        __syncthreads();
#pragma unroll
        for (int it = 0; it < 2; ++it) {
            const int tile = wave + 8 * it;
            const int tm = tile >> 2, tv = tile & 3; f32x4 a = {0.f, 0.f, 0.f, 0.f};
            a = mm16<0, 1>(ATT, 72, 16 * tm, Vt, 72, 16 * tv, 64, a, ql, g);
            a = mm16(Qg, 40, 16 * tm, Sb, 40, 16 * tv, 32, a, ql, g);
#pragma unroll
            for (int j = 0; j < 4; ++j) { const int tt = 16 * tm + 4 * g + j; hout[(size_t)scan_row(64 * c + tt, dir, latbase, ctxbase) * 256 + 64 * h + 16 * tv + ql] = (bf16)f2bf(a[j]); }
        }
        {
            const int tv = wave >> 1, td = wave & 1; f32x4 a = {0.f, 0.f, 0.f, 0.f};
            a = mm16<1, 0>(Vt, 72, 16 * tv, Kt, 72, 16 * td, 64, a, ql, g);
            const int d = 16 * td + ql; const float dec = decv[d];
#pragma unroll
            for (int j = 0; j < 4; ++j) { const int idx = (16 * tv + 4 * g + j) * 32 + d; St[idx] = dec * St[idx] + a[j]; }
        }
        __syncthreads();
    }
#undef GL_PREF
}

DI void mixers_phase(PP p, LAS unsigned char* lds, int l, bool ctx_out, bool wr, int mask, int qidx) {
    bf16* Pb = (bf16*)(p->ws + WS_BIG); float* hbuf = (float*)(p->ws + WS_HBUF);
    const int n_da = 512, n_dac = ctx_out ? 64 : 0, n_na = 1024, n_nac = ctx_out ? 128 : 0;
    const int n_rest = n_da + n_dac + n_na + n_nac;
    for (int i = obid(); i < 256; i += ogrid()) {
        if (i < 128) { if (mask & 1) mlstm_task(p, Pb, hbuf, lds, l, i >> 3, (i >> 1) & 3, i & 1); }
        else { const int i2 = i - 128; if (mask & 2) gla_task(p, Pb, hbuf, lds, l, i2 >> 3, (i2 >> 1) & 3, i2 & 1); }
    }
    asm volatile("" ::: "memory");
    const float lam_init = 0.8f - 0.6f * expf(-0.3f * (float)l);
    float lam;
    { const float* dl = p->da_lambda + l * 128; float s1 = 0.f, s2 = 0.f;
#pragma unroll 1
        for (int i = 0; i < 32; ++i) { s1 += dl[i] * dl[32 + i]; s2 += dl[64 + i] * dl[96 + i]; }
        lam = expf(s1) - expf(s2) + lam_init; }
    unsigned* ctr = (unsigned*)(p->ws + WS_BAR) + 3520 + qidx;
    volatile LAS int* slot = (volatile LAS int*)(lds + LDS_BYTES - 64 + 32);
    for (;;) {
        __syncthreads();
        if (otid() == 0) *slot = (int)__hip_atomic_fetch_add(ctr, 1u, __ATOMIC_RELAXED, __HIP_MEMORY_SCOPE_AGENT);
        __syncthreads();
        int i = *slot;
        if (i >= n_rest) break;
        if (i < n_da) { if (mask & 4) da_item(p, Pb, lds, l, false, i >> 5, (i >> 3) & 3, i & 7, lam, lam_init, wr); continue; } i -= n_da;
        if (i < n_dac) { if (mask & 4) da_item(p, Pb, lds, l, true, i >> 2, i & 3, 0, lam, lam_init, wr); continue; } i -= n_dac;
        if (!(mask & 8)) continue;
        const int tid = otid(), wave = tid >> 6;
        LAS float* bias = (LAS float*)lds; LAS bf16* Vt = (LAS bf16*)(lds + 2048 + wave * 5120);
        if (i < n_na) {
            const int bl = i >> 6, h = (i >> 4) & 3, rp = i & 15;
            __syncthreads();
            for (int e = tid; e < 465; e += 512) bias[e] = p->na_rpb[(size_t)((l * 4 + h) * 15) * 31 + e] * LOG2E;
            __syncthreads();
            na_wave(p, Pb, bias, Vt, false, bl, h, 2 * rp + (wave >> 2), wave & 3, 0, wr);
            continue;
        }
        i -= n_na;
        { const int bl = i >> 3, h = (i >> 1) & 3, hf = i & 1; __syncthreads(); na_wave(p, Pb, bias, Vt, true, bl, h, 0, 0, 128 * hf + 16 * wave, wr); }
    }
}

DI void finish_phase(PP p, int l, bool ctx_out) {
    bf16* Pb = (bf16*)(p->ws + WS_BIG); const float* hbuf = (const float*)(p->ws + WS_HBUF);
    const int wave = otid() >> 6, lane = otid() & 63;
    const int gw = obid() * 8 + wave, NGW = ogrid() * 8;
    const int nrows = ctx_out ? HROWS : 32768;
    for (int gi = gw; gi < nrows / 4; gi += NGW) {
        const int r0 = gi * 4;
        u32x2 ra[2][4], rb[2][4], rg[2][4];
#pragma unroll
        for (int br = 0; br < 2; ++br) {
            const bf16* hf = (const bf16*)hbuf + (size_t)(2 * br) * HROWS * 256 + (size_t)r0 * 256 + 4 * lane; const bf16* hb = hf + (size_t)HROWS * 256;
            const bf16* gp = Pb + (size_t)r0 * NP + (br == 0 ? C_MLO : C_GLG) + 4 * lane;
#pragma unroll
            for (int k = 0; k < 4; ++k) { ra[br][k] = *(const u32x2*)(hf + k * 256); rb[br][k] = *(const u32x2*)(hb + k * 256); rg[br][k] = *(const u32x2*)(gp + (size_t)k * NP); }
        }
#pragma unroll
        for (int br = 0; br < 2; ++br) {
            f32x4 v[4]; u32x2 gw2[4];
            bf16* gp = Pb + (size_t)r0 * NP + (br == 0 ? C_MLO : C_GLG) + 4 * lane;
#pragma unroll
            for (int k = 0; k < 4; ++k) { const u32x2 a_ = ra[br][k], b_ = rb[br][k]; v[k] = (f32x4){bflo(a_.x) + bflo(b_.x), bfhi(a_.x) + bfhi(b_.x), bflo(a_.y) + bflo(b_.y), bfhi(a_.y) + bfhi(b_.y)}; gw2[k] = rg[br][k]; }
            const f32x4 gg = *(const f32x4*)((br == 0 ? p->ml_norm_g : p->gla_norm_g) + l * 256 + 4 * lane);
#pragma unroll
            for (int k = 0; k < 4; ++k) {
                f32x4 x = v[k];
                float s = (x[0] + x[1]) + (x[2] + x[3]), q = (x[0] * x[0] + x[1] * x[1]) + (x[2] * x[2] + x[3] * x[3]);
                s += __shfl_xor(s, 1); q += __shfl_xor(q, 1); s += __shfl_xor(s, 2); q += __shfl_xor(q, 2); s += __shfl_xor(s, 4); q += __shfl_xor(q, 4); s += __shfl_xor(s, 8); q += __shfl_xor(q, 8);
                float ms = q * (1.f / 64.f);
                if (br == 0) { const float mean = s * (1.f / 64.f); x = x - mean; ms = fmaxf(ms - mean * mean, 0.f); }
                const float rn = __builtin_amdgcn_rsqf(ms + 1e-6f);
                const float gt[4] = {bflo(gw2[k].x), bfhi(gw2[k].x), bflo(gw2[k].y), bfhi(gw2[k].y)};
                float y[4];
#pragma unroll
                for (int e = 0; e < 4; ++e) { const float a = sigm(gt[e]); y[e] = (br == 0 ? a : a * gt[e]) * x[e] * rn * gg[e]; }
                u32x2 w; w.x = pk2(y[0], y[1]); w.y = pk2(y[2], y[3]); *(u32x2*)(gp + (size_t)k * NP) = w;
            }
        }
    }
}

#define XB_TMO      128
#define XB_XCNT(j)  (256  + 64 * (j))
#define XB_XSUB(j)  (1280 + 64 * (j))
#define XB_XGEN(j)  (2304 + 64 * (j))
#define XB_TOP      3328
#define XB_TOPGEN   3392
#define XCD_BAR_WORDS 3456
#define XB_SPIN_CAP (1u << 23)

__device__ __forceinline__ unsigned xb_ld(unsigned* p)              { return __hip_atomic_load(p, __ATOMIC_RELAXED, __HIP_MEMORY_SCOPE_AGENT); }
__device__ __forceinline__ unsigned xb_add(unsigned* p, unsigned v) { return __hip_atomic_fetch_add(p, v, __ATOMIC_RELAXED, __HIP_MEMORY_SCOPE_AGENT); }
__device__ __forceinline__ unsigned xb_xcc_id() { return (unsigned)__builtin_amdgcn_s_getreg((3 << 11) | 20) & 0xFu; }
#define XB_SPIN(cond, bar) do { unsigned _sp = 0; while (cond) { __builtin_amdgcn_s_sleep(1); \
    if ((++_sp & 255u) == 0u) { if (xb_ld(&(bar)[XB_TMO])) break; if (_sp > XB_SPIN_CAP) { atomicAdd(&(bar)[XB_TMO], 1u); break; } } } } while (0)

struct XcdBarrier {
    unsigned* bar; unsigned x;
    volatile LAS unsigned* st;
};

__device__ __forceinline__ XcdBarrier xcd_barrier_post(unsigned* bar, volatile LAS unsigned* st) {
    XcdBarrier b; b.bar = bar; b.x = xb_xcc_id(); b.st = st;
    if (threadIdx.x == 0) (void)xb_add(&bar[XB_XCNT(b.x)], 1u);
    return b;
}
__device__ __forceinline__ void xcd_barrier_complete(unsigned* bar, unsigned x, unsigned& nloc, unsigned& nx) {
    const unsigned G = gridDim.x * gridDim.y * gridDim.z;
    unsigned sum, cnt, mine, sp = 0u;
    for (;;) {
        sum = 0u; cnt = 0u; mine = 0u;
#pragma unroll
        for (unsigned j = 0; j < 16; ++j) { const unsigned c = xb_ld(&bar[XB_XCNT(j)]); sum += c; cnt += (c > 0u) ? 1u : 0u; mine = (j == x) ? c : mine; }
        if (sum == G) break;
        __builtin_amdgcn_s_sleep(1);
        if ((++sp & 255u) == 0u) { if (xb_ld(&bar[XB_TMO])) break; if (sp > XB_SPIN_CAP) { atomicAdd(&bar[XB_TMO], 1u); break; } }
    }
    nloc = mine > 0u ? mine : 1u; nx = cnt > 0u ? cnt : 1u;
}

__device__ __forceinline__ void xcd_barrier(const XcdBarrier& b) {
    asm volatile("s_waitcnt vmcnt(0)" ::: "memory");
    __syncthreads();
    if (threadIdx.x == 0) {
        unsigned* bar = b.bar;
        __builtin_amdgcn_s_waitcnt(0);
        unsigned nloc = b.st[0], nx = b.st[1];
        if (nloc == 0u) { xcd_barrier_complete(bar, b.x, nloc, nx); b.st[0] = nloc; b.st[1] = nx; }
        const unsigned old = xb_add(&bar[XB_XSUB(b.x)], 1u);
        const unsigned gen = old / nloc;
        if (old + 1u == (gen + 1u) * nloc) {
            __builtin_amdgcn_fence(__ATOMIC_RELEASE, "agent");
            asm volatile("s_waitcnt vmcnt(0)" ::: "memory");
            const unsigned og = xb_add(&bar[XB_TOP], 1u);
            const unsigned tg = og / nx;
            if (og + 1u == (tg + 1u) * nx) xb_add(&bar[XB_TOPGEN], 1u);
            else XB_SPIN(xb_ld(&bar[XB_TOPGEN]) == tg, bar);
            __builtin_amdgcn_fence(__ATOMIC_ACQUIRE, "agent");
            xb_add(&bar[XB_XGEN(b.x)], 1u);
            asm volatile("s_waitcnt vmcnt(0)" ::: "memory");
        } else {
            XB_SPIN(xb_ld(&bar[XB_XGEN(b.x)]) == gen, bar);
            __builtin_amdgcn_fence(__ATOMIC_ACQUIRE, "agent");
            asm volatile("s_waitcnt vmcnt(0)" ::: "memory");
        }
    }
    __syncthreads();
}


__global__ void __launch_bounds__(512) fwd_megakernel(Params pv, int ph_lo, int ph_hi) {
    extern __shared__ __attribute__((aligned(16))) unsigned char lds_raw[];
    LAS unsigned char* lds = (LAS unsigned char*)lds_raw;
    cg::grid_group grid = cg::this_grid();
    PP p = (PP)__builtin_amdgcn_kernarg_segment_ptr();
    if (ph_hi > 34) ph_hi = 34;
    volatile LAS unsigned* bst = (volatile LAS unsigned*)(lds + LDS_BYTES - 64);
    if (threadIdx.x < 2) bst[threadIdx.x] = 0u;
    __syncthreads();
    if (blockIdx.x == 0) { unsigned* bw = (unsigned*)(p->ws + WS_BAR); for (int i = threadIdx.x; i < 4096; i += 512) __hip_atomic_store(bw + i, 0u, __ATOMIC_RELAXED, __HIP_MEMORY_SCOPE_AGENT); __threadfence(); }
    grid.sync();
    XcdBarrier bar = xcd_barrier_post((unsigned*)(p->ws + WS_BAR), bst);
#if PROBE_MODE
    LAS float* TT = (LAS float*)(lds + 131072 + 1024);
    if (threadIdx.x == 0) TT[0] = 0.f;
#endif
#pragma unroll 1
    for (int ph = ph_lo; ph < ph_hi; ++ph) {
#if PROBE_MODE
        if (threadIdx.x == 0) *(LAS unsigned long long*)(TT + 2) = __builtin_amdgcn_s_memrealtime();
#endif
        bf16* hmod = (bf16*)(p->ws + WS_HMOD); bf16* big = (bf16*)(p->ws + WS_BIG);
        if (ph == 0) p0_prologue(p, lds);
        else if (ph == 1) rows_phase(p, 0, RALL, 0, 0, true, 0, 0, 1, false);
        else {
            const int l = (ph - 2) >> 4, k = (ph - 2) & 15;
            const bool ctx_out = (l == 0);
            const int nrow = ctx_out ? RALL : RLAT, npan = nrow / 256;
            if (k == 0 || k == 13) {
                const int s = k == 0 ? 0 : 1;
                pg8::ProbFfnIn q; q.K = 1024; q.lda = 1024; q.o.init(k == 0 ? 288 : npan, 22); q.A = hmod; q.Bt = (const bf16*)(p->ws + WS_WIN) + (size_t)(l * 2 + s) * 5632 * 1024; q.act = big;
                GEMM_REP(q);
            } else if (k == 1 || k == 11 || k == 14) {
                pg8::ProbRes q; q.prm = p; q.layer = l; q.first = (l == 0 && k == 1); q.lnidx = k == 1 ? (l - 1) * 3 + 2 : (k == 11 ? l * 3 : l * 3 + 1);
                if (k == 11) { q.K = 1024; q.lda = 1024; q.A = hmod; q.Bt = (const bf16*)(p->ws + WS_WO) + (size_t)l * 1024 * 1024; q.gidx = 5; q.coef = 1.0f; }
                else { q.K = DFF; q.lda = DFF; q.A = big; q.Bt = (const bf16*)(p->ws + WS_WOUTF) + (size_t)(l * 2 + (k == 1 ? 0 : 1)) * 1024 * DFF; q.gidx = k == 1 ? 2 : 8; q.coef = 0.5f; }
                q.o.init(k == 1 ? 288 : npan, 4); q.dry = 0; q.fin = (l == 1 && k == 14);
                { int nrep = REPG ? 2 : 1; asm volatile("" : "+s"(nrep));
_Pragma("unroll 1") for (int rep = 0; rep < nrep; ++rep) { q.dry = (rep + 1 < nrep); pg8::gemm_phase(lds, q); if (rep + 1 < nrep) xcd_barrier(bar); } }
            } else if (k == 2) rows_phase(p, 1, RALL, l, 0, true, l, 3, 4, false);
            else if (k == 12) rows_phase(p, 1, nrow, l, 1, true, l, 6, 7, false);
            else if (k == 15) rows_phase(p, 1, nrow, l, 2, l == 0, 1, 0, 1, l == 1);
            else {
                const int half = (k - 3) >> 2, kk = (k - 3) & 3;
                if (kk == 0) { pg8::ProbMix q; q.K = 1024; q.lda = 1024; q.o.init(144, 30); q.A = hmod; q.Bt = (const bf16*)(p->ws + WS_WMIX) + (size_t)l * NP * 1024; q.Pb = big; q.half = half; GEMM_REP(q); }
                else if (kk == 1) { if (DRY_MASK) { int dm = DRY_MASK; asm volatile("" : "+s"(dm)); mixers_phase(p, lds, l, ctx_out, dm > 100, dm, 8 + l * 2 + half); grid.sync(); } mixers_phase(p, lds, l, ctx_out, true, 15, l * 2 + half); }
                else if (kk == 2) finish_phase(p, l, ctx_out);
                else { pg8::ProbMerge q; q.K = 256; q.lda = NP; q.o.init(ctx_out ? 144 : 128, 4); q.Pb = big; q.Wb = (const bf16*)(p->ws + WS_WB) + (size_t)l * 4 * 1024 * 256; q.merged = hmod; q.half = half; GEMM_REP(q); }
            }
        }
        if (ph + 1 < ph_hi) xcd_barrier(bar);
#if PROBE_MODE
        if (threadIdx.x == 0) { int cat = 0; if (ph == 0) cat = 0; else if (ph == 1) cat = 1; else { const int k = (ph - 2) & 15; cat = (k == 0 || k == 13) ? 2 : ((k == 1 || k == 11 || k == 14) ? 3 : ((k == 2 || k == 12 || k == 15) ? 1 : (((k - 3) & 3) == 0 ? 4 : (((k - 3) & 3) == 1 ? 5 : (((k - 3) & 3) == 2 ? 6 : 7))))); }
            if (cat == PROBE_A) TT[0] += (float)(__builtin_amdgcn_s_memrealtime() - *(LAS unsigned long long*)(TT + 2)) * 0.01f; }
#endif
    }
#if PROBE_MODE
    xcd_barrier(bar);
    if (blockIdx.x == 0) { __syncthreads(); const float ta = TT[0]; for (int i = threadIdx.x; i < (1 << 20); i += 512) p->out[(1 << 20) + i] += ta * 1e-5f; }
#endif
}

extern "C" void kernel_launch(void* const* d_in, const int* in_sizes, int n_in, void* d_out, int out_size, void* d_ws, size_t ws_size, hipStream_t stream) {
    static int grid = 0;
    if (grid == 0) {
        int dev = 0, cus = 0, per_cu = 0;
        hipGetDevice(&dev);
        hipDeviceGetAttribute(&cus, hipDeviceAttributeMultiprocessorCount, dev);
        hipFuncSetAttribute((const void*)fwd_megakernel, hipFuncAttributeMaxDynamicSharedMemorySize, LDS_BYTES);
        hipOccupancyMaxActiveBlocksPerMultiprocessor(&per_cu, (const void*)fwd_megakernel, 512, LDS_BYTES);
        if (per_cu < 1) per_cu = 1;
        grid = cus * per_cu;
        if (ws_size < WS_END) fprintf(stderr, "kernel_launch: workspace too small: %zu < %zu\n", ws_size, (size_t)WS_END);
    }
    Params p{};
    const float** pp = (const float**)&p;
    for (int i = 0; i < 21; ++i) pp[i] = (const float*)d_in[i];
    p.out = (float*)d_out; p.ws = (unsigned char*)d_ws;
    int lo = 0, hi = 1000;
    void* args[] = {&p, &lo, &hi};
    hipError_t e = hipLaunchCooperativeKernel((const void*)fwd_megakernel, dim3(grid), dim3(512), args, LDS_BYTES, stream);
    if (e != hipSuccess) fprintf(stderr, "cooperative launch failed: %s (grid %d)\n", hipGetErrorString(e), grid);
}
```

```cpp
#include <hip/hip_runtime.h>
#include <hip/hip_cooperative_groups.h>
#include <cstdio>
namespace cg = cooperative_groups;

#define LAS __attribute__((address_space(3)))
typedef unsigned short bf16;
typedef short bf16x8 __attribute__((ext_vector_type(8)));
typedef short s16x4 __attribute__((ext_vector_type(4)));
typedef float f32x4 __attribute__((ext_vector_type(4)));
typedef unsigned u32x4 __attribute__((ext_vector_type(4)));
typedef unsigned u32x2 __attribute__((ext_vector_type(2)));
#define DI __device__ __forceinline__
#define LDS_WAIT() asm volatile("s_waitcnt lgkmcnt(0)" ::: "memory")
#define MFMA16(a, b, c) __builtin_amdgcn_mfma_f32_16x16x32_bf16((a), (b), (c), 0, 0, 0)

constexpr int D = 1024, SEQ = 2048, TCTX = 256, DFF = 2816;
constexpr int RLAT = 65536, RALL = 73728;
constexpr int NP = 7680;
constexpr int C_NAQ = 0, C_NAK = 256, C_NAV = 512, C_MLQ = 768, C_MLK = 1024, C_MLV = 1280, C_MLO = 1536, C_GLQ = 1792, C_GLK = 1920, C_GLV = 2048,
              C_GLG = 2304, C_DAQ = 2560, C_DAK = 2816, C_DAV = 3072, C_MLIF = 3328, C_GLA = 3344, C_GATE = 3584;
constexpr int HROWS = 36864;
constexpr float ALPHA = 1.41421356237f;
constexpr float LOG2E = 1.44269504089f;

constexpr size_t MiB = 1u << 20;
constexpr size_t WS_MODS = 1 * MiB, WS_WIN = 4 * MiB, WS_WOUTF = 48 * MiB, WS_WMIX = 70 * MiB, WS_WB = 100 * MiB, WS_WO = 104 * MiB, WS_LATC = 108 * MiB,
                 WS_HMOD = 140 * MiB, WS_BIG = 284 * MiB, WS_HBUF = WS_BIG + 540 * MiB, WS_END = WS_HBUF + 144 * MiB;
constexpr size_t WS_BAR = 768 * 1024;
constexpr int LDS_BYTES = 135168;

#ifndef PROBE_MODE
#define PROBE_MODE 0
#endif
#define DRY_MASK 0
#define REPG 0
#define GEMM_REP(q) do { int nrep = REPG ? 2 : 1; asm volatile("" : "+s"(nrep)); _Pragma("unroll 1") for (int rep = 0; rep < nrep; ++rep) { pg8::gemm_phase(lds, q); if (rep + 1 < nrep) xcd_barrier(bar); } } while (0)
#define PROBE_A 5
#define PROBE_B 2
#define PROBE_BLOCK 0
struct Params {
    const float *x, *c, *ctx, *c_ctx, *w_ada, *b_ada, *ln_g, *ln_b, *ffn_w_in, *ffn_w_out, *w_mix_in, *na_rpb, *ml_gate_b, *ml_norm_g, *gla_w_a2, *gla_b_a,
        *gla_norm_g, *da_lambda, *da_norm_g, *w_branch, *w_out;
    float* out; unsigned char* ws;
};

typedef const __attribute__((address_space(4))) Params* PP;
DI int otid() { int t = threadIdx.x; asm volatile("" : "+v"(t)); return t; }
DI int obid() { int t = blockIdx.x; asm volatile("" : "+s"(t)); return t; }
DI int ogrid() { int t = gridDim.x; asm volatile("" : "+s"(t)); return t; }
typedef __bf16 hbf2 __attribute__((ext_vector_type(2)));
typedef float f32x2 __attribute__((ext_vector_type(2)));
DI unsigned pk2(float lo, float hi) { const f32x2 v = {lo, hi}; return __builtin_bit_cast(unsigned, __builtin_convertvector(v, hbf2)); }
DI unsigned f2bf(float f) { return pk2(f, 0.f) & 0xffffu; }
DI float bf2f(unsigned short b) { return __builtin_bit_cast(float, ((unsigned)b) << 16); }
DI float bflo(unsigned w) { return __builtin_bit_cast(float, w << 16); }
DI float bfhi(unsigned w) { return __builtin_bit_cast(float, w & 0xffff0000u); }
DI float sigm(float x) { return __builtin_amdgcn_rcpf(1.f + __expf(-x)); }
DI float logsig(float x) { return fminf(x, 0.f) - log1pf(expf(-fabsf(x))); }
DI float logsig_fast(float x) { return fminf(x, 0.f) - __logf(1.f + __expf(-fabsf(x))); }
DI int grow_of(int pm, int half) { return half < 0 ? pm * 256 : (pm < 128 ? half * 32768 + pm * 256 : RLAT + half * 4096 + (pm - 128) * 256); }
DI float* latrow(PP p, int r) { return r < RLAT ? p->out + (size_t)r * D : (float*)(p->ws + WS_LATC) + (size_t)(r - RLAT) * D; }
DI bf16* ybfrow(PP p, int r) { return r < RLAT ? (bf16*)p->out + (size_t)r * D : (bf16*)(p->ws + WS_LATC) + (size_t)(r - RLAT) * D; }
DI float* yfinrow(PP p, int r) { return (float*)(p->ws + WS_BIG + 400 * MiB) + (size_t)r * D; }
DI const float* xrow(PP p, int r) { return r < RLAT ? p->x + (size_t)r * D : p->ctx + (size_t)(r - RLAT) * D; }
DI const float* modrow(PP p, int l, int r) { return (const float*)(p->ws + WS_MODS) + (size_t)(l * 33 + (r < RLAT ? (r >> 11) : 32)) * 9216; }

namespace pg8 {
constexpr int BM = 256, BK = 64, HALF = 128, HTB = HALF * BK * 2, NXCD = 8, WGM = 8;
DI int lds_byte(int r, int c) { const int st = (r >> 4) * 2 + (c >> 5), rr = r & 15, cc = c & 31, ob = rr * 64 + cc * 2; return st * 1024 + (ob ^ (((ob >> 9) & 1) << 5)); }
DI void stage_rc(int b, int& R, int& C) { const int st = b / 1024, sb = b % 1024, swz = sb ^ (((sb >> 9) & 1) << 5); R = (st >> 1) * 16 + swz / 64; C = (st & 1) * 32 + (swz % 64) / 2; }
DI int perm32(int rho) { const int n = rho >> 4, i = rho & 15; return 8 * (i >> 2) + 4 * n + (i & 3); }
struct Unit { int pm, pn, j; };
struct Order {
    int nM, nN, nwg, G, c;
    DI void init(int nM_, int nN_) { nM = nM_; nN = nN_; nwg = nM * nN; G = ogrid(); c = obid(); }
    DI bool tile(long L, Unit& u) const {
        if (L >= nwg) return false;
        int wgid = (int)L; { const int q = nwg / NXCD, r = nwg % NXCD, xcd = wgid % NXCD, off = wgid / NXCD; wgid = (xcd < r ? xcd * (q + 1) : r * (q + 1) + (xcd - r) * q) + off; }
        const int nig = WGM * nN, gid = wgid / nig, fm = gid * WGM, gsz = (nM - fm) < WGM ? (nM - fm) : WGM;
        u.pm = fm + ((wgid % nig) % gsz); u.pn = (wgid % nig) / gsz; u.j = 0; return true;
    }
};
typedef f32x4 Acc[2][2][4][2];

template <class P>
DI void gemm_phase(LAS unsigned char* lds, const P& p) {
    const int tid = otid(), wid = __builtin_amdgcn_readfirstlane(tid >> 6), lane = tid & 63, wr = wid >> 2, wc = wid & 3, fr = lane & 15, fq = lane >> 4;
    const int K = p.K, nt = K / BK; const int lda = p.lda;
    unsigned voffA[2], voffB[2];
#pragma unroll
    for (int i = 0; i < 2; ++i) { int R, C; stage_rc(tid * 16 + i * 8192, R, C); const int Rb = P::PERM ? ((R & ~31) + perm32(R & 31)) : R;
        voffA[i] = (unsigned)(R * lda + C) * 2u; voffB[i] = (unsigned)(Rb * K + C) * 2u; }
    const size_t kstep = (size_t)(BK * 2);
    const size_t hstepA = (size_t)HALF * lda * 2, hstepB = (size_t)HALF * K * 2;
    const unsigned ldsw = (unsigned)wid * 1024u;
    const int aoff = lds_byte(wr * 64 + fr, fq * 8), boff = lds_byte(wc * 32 + fr, fq * 8);
#define PG8_SA(b, h) (((b) * 2 + (h)) * HTB)
#define PG8_SB(b, h) ((4 + (b) * 2 + (h)) * HTB)
#define PG8_STAGE(bufoff, gbase, voff) do { _Pragma("unroll") for (int _i = 0; _i < 2; ++_i) \
        __builtin_amdgcn_global_load_lds((const unsigned*)((const char*)(gbase) + (voff)[_i]), (LAS unsigned*)(lds + (bufoff) + ldsw + _i * 8192), 16, 0, 0); } while (0)
#define PG8_LDA(dst, b, h) do { _Pragma("unroll") for (int m = 0; m < 4; ++m) _Pragma("unroll") for (int k = 0; k < 2; ++k) dst[m][k] = *(const LAS bf16x8*)(lds + PG8_SA(b, h) + aoff + m * 2048 + k * 1024); } while (0)
#define PG8_LDB(dst, b, h) do { _Pragma("unroll") for (int n = 0; n < 2; ++n) _Pragma("unroll") for (int k = 0; k < 2; ++k) dst[n][k] = *(const LAS bf16x8*)(lds + PG8_SB(b, h) + boff + n * 2048 + k * 1024); } while (0)
#define PG8_MMA(ai, bj, At, Bt) do { __builtin_amdgcn_s_setprio(1); _Pragma("unroll") for (int m = 0; m < 4; ++m) _Pragma("unroll") for (int n = 0; n < 2; ++n) _Pragma("unroll") for (int k = 0; k < 2; ++k) \
        acc[ai][bj][m][n] = __builtin_amdgcn_mfma_f32_16x16x32_bf16(Bt[n][k], At[m][k], acc[ai][bj][m][n], 0, 0, 0); __builtin_amdgcn_s_setprio(0); } while (0)
#define PG8_WAIT_V(n) asm volatile("s_waitcnt vmcnt(" #n ")" ::: "memory")
#define PG8_WAIT_L(n) asm volatile("s_waitcnt lgkmcnt(" #n ")" ::: "memory")
#define PG8_BAR __builtin_amdgcn_s_barrier()
#define PG8_SCHED __builtin_amdgcn_sched_barrier(0)
    Unit cur, nxt; int ui = 0;
    if (!p.next(0, cur)) return;
    Acc acc;
#pragma unroll
    for (int a = 0; a < 2; ++a)
#pragma unroll
        for (int b = 0; b < 2; ++b)
#pragma unroll
            for (int m = 0; m < 4; ++m)
#pragma unroll
                for (int n = 0; n < 2; ++n) acc[a][b][m][n] = (f32x4){0.f, 0.f, 0.f, 0.f};
    bf16x8 At[4][2], B0[2][2], B1[2][2];
    const char* cA = p.abase(cur); const char* cB = p.bbase(cur);
    PG8_STAGE(PG8_SB(0, 0), cB, voffB); PG8_STAGE(PG8_SA(0, 0), cA, voffA); PG8_STAGE(PG8_SB(0, 1), cB + hstepB, voffB); PG8_STAGE(PG8_SA(0, 1), cA + hstepA, voffA);
    if (wr == 1) PG8_BAR;
    PG8_WAIT_V(4); PG8_BAR;
    PG8_STAGE(PG8_SB(1, 0), cB + kstep, voffB); PG8_STAGE(PG8_SA(1, 0), cA + kstep, voffA); PG8_STAGE(PG8_SB(1, 1), cB + hstepB + kstep, voffB);
    PG8_WAIT_V(6); PG8_BAR;
    for (;;) {
        const bool has_next = p.next(ui + 1, nxt);
        const char* nA = has_next ? p.abase(nxt) : cA; const char* nB = has_next ? p.bbase(nxt) : cB;
        for (int t = 0; t < nt; t += 2) {
            const bool last = (t == nt - 2);
            const char* a1 = cA + (size_t)(t + 1) * kstep;
            const char* a2 = last ? nA : cA + (size_t)(t + 2) * kstep; const char* b2 = last ? nB : cB + (size_t)(t + 2) * kstep;
            const char* a3 = a2 + kstep; const char* b3 = b2 + kstep;
            PG8_LDB(B0, 0, 0); PG8_SCHED; PG8_LDA(At, 0, 0); PG8_STAGE(PG8_SA(1, 1), a1 + hstepA, voffA);
            PG8_WAIT_L(8); PG8_BAR; PG8_WAIT_L(0); PG8_MMA(0, 0, At, B0); PG8_BAR; PG8_SCHED;
            PG8_LDB(B1, 0, 1); PG8_STAGE(PG8_SB(0, 0), b2, voffB);
            PG8_BAR; PG8_WAIT_L(0); PG8_MMA(0, 1, At, B1); PG8_BAR;
            PG8_LDA(At, 0, 1); PG8_STAGE(PG8_SA(0, 0), a2, voffA);
            PG8_BAR; PG8_WAIT_L(0); PG8_MMA(1, 0, At, B0); PG8_BAR; PG8_SCHED;
            PG8_STAGE(PG8_SB(0, 1), b2 + hstepB, voffB);
            PG8_WAIT_V(6); PG8_BAR; PG8_MMA(1, 1, At, B1); PG8_BAR;
            PG8_LDB(B0, 1, 0); PG8_SCHED; PG8_LDA(At, 1, 0); PG8_STAGE(PG8_SA(0, 1), a2 + hstepA, voffA);
            PG8_WAIT_L(8); PG8_BAR; PG8_WAIT_L(0); PG8_MMA(0, 0, At, B0); PG8_BAR; PG8_SCHED;
            PG8_LDB(B1, 1, 1); PG8_STAGE(PG8_SB(1, 0), b3, voffB);
            PG8_BAR; PG8_WAIT_L(0); PG8_MMA(0, 1, At, B1); PG8_BAR;
            PG8_LDA(At, 1, 1); PG8_STAGE(PG8_SA(1, 0), a3, voffA);
            PG8_BAR; PG8_WAIT_L(0); PG8_MMA(1, 0, At, B0); PG8_BAR; PG8_SCHED;
            PG8_STAGE(PG8_SB(1, 1), b3 + hstepB, voffB);
            PG8_WAIT_V(6); PG8_BAR; PG8_MMA(1, 1, At, B1); PG8_BAR;
        }
        p.epi(acc, cur, wr, wc, fr, fq);
        if (!has_next) break;
        if (!P::KEEP) {
#pragma unroll
            for (int a = 0; a < 2; ++a)
#pragma unroll
                for (int b = 0; b < 2; ++b)
#pragma unroll
                    for (int m = 0; m < 4; ++m)
#pragma unroll
                        for (int n = 0; n < 2; ++n) acc[a][b][m][n] = (f32x4){0.f, 0.f, 0.f, 0.f};
        }
        cur = nxt; cA = nA; cB = nB; ++ui;
    }
    PG8_WAIT_V(0);
    if (wr == 0) PG8_BAR;
    PG8_BAR;
#undef PG8_SA
#undef PG8_SB
#undef PG8_STAGE
#undef PG8_LDA
#undef PG8_LDB
#undef PG8_MMA
#undef PG8_WAIT_V
#undef PG8_WAIT_L
#undef PG8_BAR
#undef PG8_SCHED
}

struct ProbFfnIn {
    static constexpr bool PERM = true, KEEP = false;
    int K, lda; Order o; const bf16* A; const bf16* Bt; bf16* act;
    DI bool next(int i, Unit& u) const { return o.tile((long)i * o.G + o.c, u); }
    DI const char* abase(const Unit& u) const { return (const char*)(A + (size_t)u.pm * 256 * lda); }
    DI const char* bbase(const Unit& u) const { return (const char*)(Bt + (size_t)u.pn * 256 * K); }
    DI void epi(Acc& acc, const Unit& u, int wr, int wc, int fr, int fq) const {
#pragma unroll
        for (int ai = 0; ai < 2; ++ai)
#pragma unroll
            for (int m = 0; m < 4; ++m) {
                const int row = u.pm * 256 + ai * 128 + wr * 64 + m * 16 + fr;
                float o8[8];
#pragma unroll
                for (int n = 0; n < 2; ++n)
#pragma unroll
                    for (int e = 0; e < 4; ++e) { const float a = acc[ai][0][m][n][e], b = acc[ai][1][m][n][e]; o8[n * 4 + e] = a * sigm(a) * b; }
                u32x4 w; w.x = pk2(o8[0], o8[1]); w.y = pk2(o8[2], o8[3]); w.z = pk2(o8[4], o8[5]); w.w = pk2(o8[6], o8[7]);
                *(u32x4*)(act + (size_t)row * DFF + u.pn * 128 + wc * 32 + 8 * fq) = w;
            }
    }
};
struct ProbRes {
    static constexpr bool PERM = true, KEEP = false;
    int K, lda; Order o; const bf16* A; const bf16* Bt; PP prm; int layer, gidx, first, lnidx, dry, fin; float coef;
    DI bool next(int i, Unit& u) const { return o.tile((long)i * o.G + o.c, u); }
    DI const char* abase(const Unit& u) const { return (const char*)(A + (size_t)u.pm * 256 * lda); }
    DI const char* bbase(const Unit& u) const { return (const char*)(Bt + (size_t)u.pn * 256 * K); }
    DI void epi(Acc& acc, const Unit& u, int wr, int wc, int fr, int fq) const {
        int pm_ = u.pm, pn_ = u.pn; asm volatile("" : "+s"(pm_), "+s"(pn_));
        const int r0 = pm_ * 256;
        const float* gate = modrow(prm, layer, r0) + gidx * D;
        bf16* yb = ybfrow(prm, r0); bf16* yo = fin ? (bf16*)yfinrow(prm, 0) + (size_t)r0 * D : yb;
        const f32x2* stats = (const f32x2*)(prm->ws) + r0;
        const int col0 = pn_ * 256 + wc * 32 + 8 * fq;
        const float* lg = prm->ln_g + (size_t)(first ? 0 : lnidx) * D; const float* lb = prm->ln_b + (size_t)(first ? 0 : lnidx) * D;
#pragma unroll
        for (int bj = 0; bj < 2; ++bj) {
            const int c = col0 + bj * 128;
            f32x4 g4[2], lg4[2], lb4[2];
#pragma unroll
            for (int n = 0; n < 2; ++n) { g4[n] = *(const f32x4*)(gate + c + 4 * n) * coef; lg4[n] = *(const f32x4*)(lg + c + 4 * n) * ALPHA; lb4[n] = *(const f32x4*)(lb + c + 4 * n) * ALPHA;
                if (first) { lg4[n] = (f32x4){ALPHA, ALPHA, ALPHA, ALPHA}; lb4[n] = (f32x4){0.f, 0.f, 0.f, 0.f}; } }
            {
                u32x4 rb[2][4];
#pragma unroll
                for (int ai = 0; ai < 2; ++ai)
#pragma unroll
                    for (int m = 0; m < 4; ++m) rb[ai][m] = *(const u32x4*)(yb + (size_t)(ai * 128 + wr * 64 + m * 16 + fr) * D + c);
#pragma unroll
                for (int ai = 0; ai < 2; ++ai)
#pragma unroll
                    for (int m = 0; m < 4; ++m) {
                        const u32x4 q = rb[ai][m]; f32x2 stv = stats[ai * 128 + wr * 64 + m * 16 + fr]; if (first) stv = (f32x2){0.f, 1.f}; const float mean = stv.x, rs = stv.y;
                        const f32x4 r0v = {bflo(q.x), bfhi(q.x), bflo(q.y), bfhi(q.y)}, r1v = {bflo(q.z), bfhi(q.z), bflo(q.w), bfhi(q.w)};
                        const f32x4 o0 = ((r0v - mean) * rs) * lg4[0] + lb4[0] + g4[0] * acc[ai][bj][m][0], o1 = ((r1v - mean) * rs) * lg4[1] + lb4[1] + g4[1] * acc[ai][bj][m][1];
                        const size_t off = (size_t)(ai * 128 + wr * 64 + m * 16 + fr) * D + c;
                        { u32x4 w; w.x = pk2(o0[0], o0[1]); w.y = pk2(o0[2], o0[3]); w.z = pk2(o1[0], o1[1]); w.w = pk2(o1[2], o1[3]); if (!dry) *(u32x4*)(yo + off) = w; }
                    }
                asm volatile("" ::: "memory");
            }
        }
    }
};
struct ProbMix {
    static constexpr bool PERM = true, KEEP = false;
    int K, lda; Order o; const bf16* A; const bf16* Bt; bf16* Pb; int half;
    DI bool next(int i, Unit& u) const { return o.tile((long)i * o.G + o.c, u); }
    DI const char* abase(const Unit& u) const { return (const char*)(A + (size_t)grow_of(u.pm, half) * lda); }
    DI const char* bbase(const Unit& u) const { return (const char*)(Bt + (size_t)u.pn * 256 * K); }
    DI void epi(Acc& acc, const Unit& u, int wr, int wc, int fr, int fq) const {
        const bool sg = u.pn >= 14;
#pragma unroll
        for (int ai = 0; ai < 2; ++ai)
#pragma unroll
            for (int m = 0; m < 4; ++m) {
                const int row = u.pm * 256 + ai * 128 + wr * 64 + m * 16 + fr;
#pragma unroll
                for (int bj = 0; bj < 2; ++bj) {
                    f32x4 v0 = acc[ai][bj][m][0], v1 = acc[ai][bj][m][1];
                    if (sg) {
#pragma unroll
                        for (int e = 0; e < 4; ++e) { v0[e] = sigm(v0[e]); v1[e] = sigm(v1[e]); }
                    }
                    u32x4 w; w.x = pk2(v0[0], v0[1]); w.y = pk2(v0[2], v0[3]); w.z = pk2(v1[0], v1[1]); w.w = pk2(v1[2], v1[3]);
                    *(u32x4*)(Pb + (size_t)row * NP + u.pn * 256 + bj * 128 + wc * 32 + 8 * fq) = w;
                }
            }
    }
};
struct ProbMerge {
    static constexpr bool PERM = true, KEEP = true;
    int K, lda; Order o; const bf16* Pb; const bf16* Wb; bf16* merged; int half;
    DI bool next(int i, Unit& u) const { const bool ok = o.tile((long)(i >> 2) * o.G + o.c, u); u.j = i & 3; return ok; }
    DI int acol(int j) const { return j == 0 ? C_NAQ : (j == 1 ? C_MLO : (j == 2 ? C_GLG : C_DAQ)); }
    DI const char* abase(const Unit& u) const { return (const char*)(Pb + (size_t)u.pm * 256 * lda + acol(u.j)); }
    DI const char* bbase(const Unit& u) const { return (const char*)(Wb + (size_t)u.j * 1024 * 256 + (size_t)u.pn * 256 * K); }
    DI void epi(Acc& acc, const Unit& u, int wr, int wc, int fr, int fq) const {
        const int j = u.j; const int grow0 = grow_of(u.pm, half);
        const bf16* gp0 = Pb + (size_t)(u.pm * 256 + wr * 64 + fr) * NP + C_GATE + j * 1024 + u.pn * 256 + wc * 32 + 8 * fq;
        const bool fin = (j == 3); const int nxt_off = fin ? 0 : 1024;
#pragma unroll
        for (int ai = 0; ai < 2; ++ai) {
            u32x4 ga[4][2], gb[4][2];
#pragma unroll
            for (int m = 0; m < 4; ++m)
#pragma unroll
                for (int bj = 0; bj < 2; ++bj) { const bf16* gp = gp0 + (size_t)(ai * 128 + m * 16) * NP + bj * 128; ga[m][bj] = *(const u32x4*)gp; gb[m][bj] = *(const u32x4*)(gp + nxt_off); }
#pragma unroll
            for (int m = 0; m < 4; ++m)
#pragma unroll
                for (int bj = 0; bj < 2; ++bj) {
                    const u32x4 a = ga[m][bj], b = gb[m][bj];
                    const float s[8] = {bflo(a.x), bfhi(a.x), bflo(a.y), bfhi(a.y), bflo(a.z), bfhi(a.z), bflo(a.w), bfhi(a.w)};
                    const float t[8] = {bflo(b.x), bfhi(b.x), bflo(b.y), bfhi(b.y), bflo(b.z), bfhi(b.z), bflo(b.w), bfhi(b.w)};
                    float o8[8];
#pragma unroll
                    for (int n = 0; n < 2; ++n)
#pragma unroll
                        for (int e = 0; e < 4; ++e) {
                            const float v = acc[ai][bj][m][n][e] * s[n * 4 + e];
                            o8[n * 4 + e] = v;
                            acc[ai][bj][m][n][e] = fin ? 0.f : v * __builtin_amdgcn_rcpf(fmaxf(t[n * 4 + e], 1e-30f));
                        }
                    if (fin) {
                        u32x4 w; w.x = pk2(o8[0], o8[1]); w.y = pk2(o8[2], o8[3]); w.z = pk2(o8[4], o8[5]); w.w = pk2(o8[6], o8[7]);
                        *(u32x4*)(merged + (size_t)(grow0 + ai * 128 + wr * 64 + m * 16 + fr) * D + u.pn * 256 + bj * 128 + wc * 32 + 8 * fq) = w;
                    }
                }
            asm volatile("" ::: "memory");
        }
    }
};
}

DI int map_ident(int n) { return n; }
DI int map_ffn(int n) { const int t = n >> 8, w = n & 255; return (w >> 7) * DFF + t * 128 + (w & 127); }
DI int map_mix(int n) {
    if (n < 1792) return n;
    if (n < 2560) return n + 16;
    if (n < 3328) return n + 48;
    if (n < 3344) return 1792 + (n - 3328);
    if (n < 3376) return 2576 + (n - 3344);
    if (n < 3584) return -1;
    return 3376 + (n - 3584);
}
template <int MAP>
DI void transpose_item(const float* W, int K, int Nsrc, bf16* WT, LAS float* scr, int kb, int nb, int lane) {
    const int k0 = 64 * kb, n0 = 32 * nb;
    const int nq = (lane & 7) * 4, kr = lane >> 3;
    const int nn = n0 + nq;
    const int sc = MAP == 0 ? map_ident(nn) : (MAP == 1 ? map_ffn(nn) : map_mix(nn));
    f32x4 v[8];
#pragma unroll
    for (int i = 0; i < 8; ++i) v[i] = sc >= 0 ? *(const f32x4*)(W + (size_t)(k0 + 8 * i + kr) * Nsrc + sc) : (f32x4){0.f, 0.f, 0.f, 0.f};
#pragma unroll
    for (int i = 0; i < 8; ++i) { LAS float* d = scr + (8 * i + kr) * 33 + nq; d[0] = v[i].x; d[1] = v[i].y; d[2] = v[i].z; d[3] = v[i].w; }
    LDS_WAIT();
    const int c = lane & 7;
#pragma unroll
    for (int j = 0; j < 4; ++j) { const int n = (lane >> 3) + 8 * j; const LAS float* s = scr + (8 * c) * 33 + n;
        u32x4 o; o.x = pk2(s[0 * 33], s[1 * 33]); o.y = pk2(s[2 * 33], s[3 * 33]); o.z = pk2(s[4 * 33], s[5 * 33]); o.w = pk2(s[6 * 33], s[7 * 33]);
        *(u32x4*)(WT + (size_t)(n0 + n) * K + k0 + 8 * c) = o; }
    LDS_WAIT();
}

DI void mods_item(PP p, LAS float* lds, int item) {
    const int l = item / 72, cbk = item % 72;
    const int tid = otid(), col = tid & 127, g = tid >> 7;
    LAS float* sc = lds; LAS float* red = lds + 33 * 128;
    float acc[33];
#pragma unroll
    for (int r = 0; r < 33; ++r) acc[r] = 0.f;
    const float* W = p->w_ada + (size_t)l * 1024 * 9216 + 128 * cbk + col;
    for (int kc = 0; kc < 8; ++kc) {
        __syncthreads();
        for (int e = tid; e < 33 * 128; e += 512) { const int r = e >> 7, kk = e & 127; const float v = r < 32 ? p->c[r * 1024 + kc * 128 + kk] : p->c_ctx[kc * 128 + kk]; sc[e] = v / (1.f + expf(-v)); }
        __syncthreads();
        for (int kk0 = 0; kk0 < 32; kk0 += 8) {
            float wv[8];
#pragma unroll
            for (int u = 0; u < 8; ++u) wv[u] = W[(size_t)(kc * 128 + g * 32 + kk0 + u) * 9216];
#pragma unroll
            for (int u = 0; u < 8; ++u) { const int k = g * 32 + kk0 + u;
#pragma unroll
                for (int r = 0; r < 33; ++r) acc[r] += sc[r * 128 + k] * wv[u]; }
        }
    }
#pragma unroll
    for (int r = 0; r < 33; ++r) red[(g * 33 + r) * 128 + col] = acc[r];
    __syncthreads();
    float* mods = (float*)(p->ws + WS_MODS);
    for (int e = tid; e < 33 * 128; e += 512) { const int r = e >> 7, cc = e & 127;
        const float v = red[(0 * 33 + r) * 128 + cc] + red[(1 * 33 + r) * 128 + cc] + red[(2 * 33 + r) * 128 + cc] + red[(3 * 33 + r) * 128 + cc];
        mods[(size_t)(l * 33 + r) * 9216 + 128 * cbk + cc] = v + p->b_ada[l * 9216 + 128 * cbk + cc]; }
    __syncthreads();
}

DI void p0_prologue(PP p, LAS unsigned char* lds) {
    for (int it = obid(); it < 144; it += ogrid()) mods_item(p, (LAS float*)lds, it);
    __syncthreads();
    const int wave = otid() >> 6, lane = otid() & 63;
    LAS float* scr = (LAS float*)(lds + wave * 8704);
    const int gw = obid() * 8 + wave, NGW = ogrid() * 8;
    constexpr int I_IN = 16 * 176, I_OUT = 44 * 32, I_MIX = 16 * 240, I_B = 4 * 32, I_O = 16 * 32;
    constexpr int NITEMS = 4 * I_IN + 4 * I_OUT + 2 * I_MIX + 8 * I_B + 2 * I_O;
    static_assert(NITEMS % 64 == 0, "chunking");
    unsigned* ctr = (unsigned*)(p->ws + WS_BAR) + 3600;
    volatile LAS int* slot = (volatile LAS int*)(lds + LDS_BYTES - 64 + 48);
    (void)gw; (void)NGW;
    for (;;) {
        __syncthreads();
        if (otid() == 0) *slot = (int)__hip_atomic_fetch_add(ctr, 1u, __ATOMIC_RELAXED, __HIP_MEMORY_SCOPE_AGENT);
        __syncthreads();
        const int chunk = *slot;
        if (chunk >= NITEMS / 64) break;
      for (int sub = 0; sub < 8; ++sub) {
        const int it = chunk * 64 + wave * 8 + sub;
        int r = it;
        if (r < 4 * I_IN) { const int w = r / I_IN, q = r % I_IN; transpose_item<1>(p->ffn_w_in + (size_t)w * 1024 * 5632, 1024, 5632, (bf16*)(p->ws + WS_WIN) + (size_t)w * 5632 * 1024, scr, q / 176, q % 176, lane); continue; } r -= 4 * I_IN;
        if (r < 4 * I_OUT) { const int w = r / I_OUT, q = r % I_OUT; transpose_item<0>(p->ffn_w_out + (size_t)w * DFF * 1024, DFF, 1024, (bf16*)(p->ws + WS_WOUTF) + (size_t)w * 1024 * DFF, scr, q / 32, q % 32, lane); continue; } r -= 4 * I_OUT;
        if (r < 2 * I_MIX) { const int w = r / I_MIX, q = r % I_MIX; transpose_item<2>(p->w_mix_in + (size_t)w * 1024 * 7472, 1024, 7472, (bf16*)(p->ws + WS_WMIX) + (size_t)w * NP * 1024, scr, q / 240, q % 240, lane); continue; } r -= 2 * I_MIX;
        if (r < 8 * I_B) { const int w = r / I_B, q = r % I_B; transpose_item<0>(p->w_branch + (size_t)w * 256 * 1024, 256, 1024, (bf16*)(p->ws + WS_WB) + (size_t)w * 1024 * 256, scr, q / 32, q % 32, lane); continue; } r -= 8 * I_B;
        { const int w = r / I_O, q = r % I_O; transpose_item<0>(p->w_out + (size_t)w * 1024 * 1024, 1024, 1024, (bf16*)(p->ws + WS_WO) + (size_t)w * 1024 * 1024, scr, q / 32, q % 32, lane); }
      }
    }
}

DI float wave_sum(float v) {
#pragma unroll
    for (int o = 1; o < 64; o <<= 1) v += __shfl_xor(v, o);
    return v;
}
DI void rows_phase(PP p, int mode, int nrows, int lnl, int lnw, bool hm, int ml, int ishift, int iscale, bool fin) {
    const int wave = otid() >> 6, lane = otid() & 63;
    const int gw = obid() * 8 + wave, NGW = ogrid() * 8;
    bf16* hmod = (bf16*)(p->ws + WS_HMOD);
    u32x2 pre[4][4];
#define ROWS_YPTR(r0_) ((fin ? (const u32x2*)((const bf16*)yfinrow(p, 0) + (size_t)(r0_) * D) : (const u32x2*)ybfrow(p, (r0_))) + lane)
    if (mode != 0 && gw < nrows / 4) { const u32x2* yr = ROWS_YPTR(gw * 4);
#pragma unroll
        for (int k = 0; k < 4; ++k)
#pragma unroll
            for (int j = 0; j < 4; ++j) pre[k][j] = yr[k * 256 + 64 * j]; }
    f32x4 prex[4][4];
    if (mode == 0 && gw < nrows / 4) { const f32x4* xr = (const f32x4*)xrow(p, gw * 4) + lane;
#pragma unroll
        for (int k = 0; k < 4; ++k)
#pragma unroll
            for (int j = 0; j < 4; ++j) prex[k][j] = xr[k * 256 + 64 * j]; }
    for (int gi = gw; gi < nrows / 4; gi += NGW) {
        const int r0 = gi * 4;
        f32x4 v[4][4];
        if (mode == 0) {
            u32x2* yw = (u32x2*)ybfrow(p, r0) + lane;
#pragma unroll
            for (int k = 0; k < 4; ++k)
#pragma unroll
                for (int j = 0; j < 4; ++j) v[k][j] = prex[k][j];
            if (gi + NGW < nrows / 4) { const f32x4* xr = (const f32x4*)xrow(p, (gi + NGW) * 4) + lane;
#pragma unroll
                for (int k = 0; k < 4; ++k)
#pragma unroll
                    for (int j = 0; j < 4; ++j) prex[k][j] = xr[k * 256 + 64 * j]; }
#pragma unroll
            for (int k = 0; k < 4; ++k)
#pragma unroll
                for (int j = 0; j < 4; ++j) { u32x2 w; w.x = pk2(v[k][j].x, v[k][j].y); w.y = pk2(v[k][j].z, v[k][j].w); yw[k * 256 + 64 * j] = w; }
        } else {
            f32x4* lr = (f32x4*)latrow(p, r0) + lane; float s[4];
#pragma unroll
            for (int k = 0; k < 4; ++k)
#pragma unroll
                for (int j = 0; j < 4; ++j) { const u32x2 q = pre[k][j]; v[k][j] = (f32x4){bflo(q.x), bfhi(q.x), bflo(q.y), bfhi(q.y)}; }
            if (gi + NGW < nrows / 4) { const u32x2* yr = ROWS_YPTR((gi + NGW) * 4);
#pragma unroll
                for (int k = 0; k < 4; ++k)
#pragma unroll
                    for (int j = 0; j < 4; ++j) pre[k][j] = yr[k * 256 + 64 * j]; }
            float s2[4];
#pragma unroll
            for (int k = 0; k < 4; ++k) { s[k] = 0.f; s2[k] = 0.f;
#pragma unroll
                for (int j = 0; j < 4; ++j) { s[k] += (v[k][j].x + v[k][j].y) + (v[k][j].z + v[k][j].w); s2[k] += (v[k][j].x * v[k][j].x + v[k][j].y * v[k][j].y) + (v[k][j].z * v[k][j].z + v[k][j].w * v[k][j].w); } }
#pragma unroll
            for (int o = 1; o < 64; o <<= 1) {
#pragma unroll
                for (int k = 0; k < 4; ++k) { s[k] += __shfl_xor(s[k], o); s2[k] += __shfl_xor(s2[k], o); } }
#pragma unroll
            for (int k = 0; k < 4; ++k) { const float mean = s[k] * (1.f / D); s2[k] = fmaxf(s2[k] * (1.f / D) - mean * mean, 0.f) * D;
#pragma unroll
                for (int j = 0; j < 4; ++j) v[k][j] = v[k][j] - mean; }
            const f32x4* gg = (const f32x4*)(p->ln_g + (size_t)(lnl * 3 + lnw) * D) + lane; const f32x4* bb = (const f32x4*)(p->ln_b + (size_t)(lnl * 3 + lnw) * D) + lane;
            float rstd[4];
#pragma unroll
            for (int k = 0; k < 4; ++k) rstd[k] = __builtin_amdgcn_rsqf(s2[k] * (1.f / D) + 1e-5f);
            if (!fin && lane < 4) { f32x2* stats = (f32x2*)(p->ws) + r0; const float mk = lane == 0 ? s[0] : (lane == 1 ? s[1] : (lane == 2 ? s[2] : s[3])), rk = lane == 0 ? rstd[0] : (lane == 1 ? rstd[1] : (lane == 2 ? rstd[2] : rstd[3]));
                stats[lane] = (f32x2){mk * (1.f / D), rk}; }
#pragma unroll
            for (int j = 0; j < 4; ++j) { const f32x4 g4 = gg[64 * j], b4 = bb[64 * j];
#pragma unroll
                for (int k = 0; k < 4; ++k) { v[k][j] = v[k][j] * rstd[k] * g4 + b4; if (fin) lr[k * 256 + 64 * j] = v[k][j]; } }
        }
        if (hm) {
            const float* mr = modrow(p, ml, r0);
            const f32x4* sh = (const f32x4*)(mr + ishift * D) + lane; const f32x4* sc = (const f32x4*)(mr + iscale * D) + lane;
            u32x2* o8 = (u32x2*)(hmod + (size_t)r0 * D) + lane;
#pragma unroll
            for (int j = 0; j < 4; ++j) { const f32x4 sc4 = sc[64 * j] + 1.f, sh4 = sh[64 * j];
#pragma unroll
                for (int k = 0; k < 4; ++k) { const f32x4 h = v[k][j] * sc4 + sh4; u32x2 w; w.x = pk2(h.x, h.y); w.y = pk2(h.z, h.w); o8[k * 256 + 64 * j] = w; } }
        }
    }
}

#undef ROWS_YPTR
DI bf16x8 ld8(const bf16* p) { return *(const bf16x8*)p; }
DI bf16x8 cat4(s16x4 a, s16x4 b) { return __builtin_shufflevector(a, b, 0, 1, 2, 3, 4, 5, 6, 7); }
DI int perm64(int r) { return r < 64 ? 8 * (r & 7) + (r >> 3) : r; }
template <int PA = 0, int PB = 0>
DI f32x4 mm16(const LAS bf16* A, int lda, int m0, const LAS bf16* B, int ldb, int n0, int K, f32x4 acc, int ql, int g) {
    const int ra = PA ? perm64(m0 + ql) : m0 + ql, rb = PB ? perm64(n0 + ql) : n0 + ql;
#pragma unroll
    for (int k0 = 0; k0 < K; k0 += 32) {
        const bf16x8 a = *(const LAS bf16x8*)(A + ra * lda + k0 + 8 * g);
        const bf16x8 b = *(const LAS bf16x8*)(B + rb * ldb + k0 + 8 * g);
        acc = MFMA16(a, b, acc);
    }
    return acc;
}

DI void da_item(PP p, bf16* Pb, LAS unsigned char* lds, int l, bool ctxq, int bl, int h, int qb, float lam, float lam_init, bool wr) {
    LAS float* tab = (LAS float*)(lds + 38912); LAS float* red = (LAS float*)(lds + 43008);
    const int tid = otid(), wave = tid >> 6, lane = tid & 63, g = lane >> 4, ql = lane & 15;
    const int latbase = bl * 2048, ctxbase = 32768 + bl * 256;
    const int ntiles = ctxq ? 4 : 36;
    __syncthreads();
    { const int pos = tid >> 3, i = tid & 7; const float inv = exp2f(-(float)i * (13.287712379549449f / 8.f)); float s, c; sincosf((float)pos * inv, &s, &c); tab[tid * 2] = c; tab[tid * 2 + 1] = s; }
    {
        float m1 = 0.f, m2 = 0.f;
        for (int kk = tid; kk < ntiles * 64; kk += 512) {
            const int row = (!ctxq && kk < 2048) ? latbase + kk : ctxbase + (ctxq ? kk : kk - 2048);
            const bf16* kp = Pb + (size_t)row * NP + C_DAK + 64 * h;
            float n1 = 0.f, n2 = 0.f;
#pragma unroll
            for (int c4 = 0; c4 < 4; ++c4) { const bf16x8 a = ld8(kp + 8 * c4), b2 = ld8(kp + 32 + 8 * c4);
#pragma unroll
                for (int e = 0; e < 8; ++e) { const float x = bf2f((unsigned short)a[e]), y = bf2f((unsigned short)b2[e]); n1 += x * x; n2 += y * y; } }
            m1 = fmaxf(m1, n1); m2 = fmaxf(m2, n2);
        }
#pragma unroll
        for (int o = 1; o < 64; o <<= 1) { m1 = fmaxf(m1, __shfl_xor(m1, o)); m2 = fmaxf(m2, __shfl_xor(m2, o)); }
        if (lane == 0) { red[wave * 2] = m1; red[wave * 2 + 1] = m2; }
    }
    __syncthreads();
    float kmax[2];
    { float m1 = 0.f, m2 = 0.f;
#pragma unroll
        for (int w = 0; w < 8; ++w) { m1 = fmaxf(m1, red[w * 2]); m2 = fmaxf(m2, red[w * 2 + 1]); }
        kmax[0] = sqrtf(m1) * 1.01f; kmax[1] = sqrtf(m2) * 1.01f; }
    const float qscale = 0.17677669529663687f * LOG2E;
    bf16x8 qf[2][2]; float mref[2][2];
#pragma unroll
    for (int mp = 0; mp < 2; ++mp)
#pragma unroll
        for (int qg = 0; qg < 2; ++qg) {
            const int tq = (ctxq ? 0 : qb * 256) + wave * 32 + qg * 16 + ql;
            const bf16* qp = Pb + (size_t)((ctxq ? ctxbase : latbase) + tq) * NP + C_DAQ + 64 * h + 32 * mp;
            const bf16x8 own = ld8(qp + 8 * g), oth = ld8(qp + 8 * (g ^ 1));
            float o[8];
            if (ctxq) {
#pragma unroll
                for (int e = 0; e < 8; ++e) o[e] = bf2f((unsigned short)own[e]);
            } else {
                const int pos = (g < 2) ? (tq >> 6) : (tq & 63);
#pragma unroll
                for (int e = 0; e < 8; ++e) { const float c = tab[(pos * 8 + e) * 2], sn = tab[(pos * 8 + e) * 2 + 1]; const float a = bf2f((unsigned short)own[e]), b2 = bf2f((unsigned short)oth[e]);
                    o[e] = (g & 1) ? (b2 * sn + a * c) : (a * c - b2 * sn); }
            }
            float nn = 0.f;
#pragma unroll
            for (int e = 0; e < 8; ++e) { o[e] *= qscale; nn += o[e] * o[e]; }
            nn += __shfl_xor(nn, 16); nn += __shfl_xor(nn, 32);
            mref[mp][qg] = sqrtf(nn) * 1.01f * kmax[mp];
            u32x4 w; w.x = pk2(o[0], o[1]); w.y = pk2(o[2], o[3]); w.z = pk2(o[4], o[5]); w.w = pk2(o[6], o[7]);
            qf[mp][qg] = __builtin_bit_cast(bf16x8, w);
        }
    f32x4 O[2][2][4]; float lsum[2][2];
#pragma unroll
    for (int a = 0; a < 2; ++a)
#pragma unroll
        for (int b2 = 0; b2 < 2; ++b2) { lsum[a][b2] = 0.f;
#pragma unroll
            for (int k = 0; k < 4; ++k) O[a][b2][k] = (f32x4){0.f, 0.f, 0.f, 0.f}; }
    const int skey = tid >> 3, smp = (tid >> 2) & 1, ssec = (tid >> 1) & 1, shf = tid & 1, vseg = tid & 7;
    bf16x8 pre0, pre1, pre2;
#define DA_PREFETCH(kt_) do { const int kt__ = (kt_); const bool lk = !ctxq && kt__ < 32; const int kr0 = lk ? latbase + kt__ * 64 : ctxbase + (ctxq ? kt__ : kt__ - 32) * 64; \
        const bf16* rp = Pb + (size_t)(kr0 + skey) * NP + 64 * h; const bf16* kp = rp + C_DAK + 32 * smp + 16 * ssec; pre0 = ld8(kp); pre1 = ld8(kp + 8); pre2 = ld8(rp + C_DAV + 8 * vseg); } while (0)
#define DA_STAGE(kt_) do { const int kt__ = (kt_); const bool lk = !ctxq && kt__ < 32; LAS unsigned char* bb = lds + (kt__ & 1) * 19456; \
        LAS bf16* dst = (LAS bf16*)(bb + smp * 5120) + skey * 40 + 16 * ssec + 8 * shf; \
        if (lk) { const int pos = ssec == 0 ? kt__ : skey; float o[8]; \
            _Pragma("unroll") for (int e = 0; e < 8; ++e) { const float c = tab[(pos * 8 + e) * 2], sn = tab[(pos * 8 + e) * 2 + 1]; const float a = bf2f((unsigned short)pre0[e]), b2 = bf2f((unsigned short)pre1[e]); o[e] = shf ? (a * sn + b2 * c) : (a * c - b2 * sn); } \
            u32x4 w1; w1.x = pk2(o[0], o[1]); w1.y = pk2(o[2], o[3]); w1.z = pk2(o[4], o[5]); w1.w = pk2(o[6], o[7]); *(LAS u32x4*)dst = w1; \
        } else { *(LAS bf16x8*)dst = shf ? pre1 : pre0; } \
        LAS bf16* Vw = (LAS bf16*)(bb + 10240); \
        _Pragma("unroll") for (int e = 0; e < 8; ++e) Vw[(8 * e + vseg) * 72 + skey] = (bf16)pre2[e]; } while (0)
    DA_PREFETCH(0);
    DA_STAGE(0);
    if (ntiles > 1) DA_PREFETCH(1);
    __syncthreads();
    for (int kt = 0; kt < ntiles; ++kt) {
        if (kt + 1 < ntiles) DA_STAGE(kt + 1);
        if (kt + 2 < ntiles) DA_PREFETCH(kt + 2);
        LAS unsigned char* bb = lds + (kt & 1) * 19456;
        const LAS bf16* K1s = (const LAS bf16*)bb; const LAS bf16* K2s = (const LAS bf16*)(bb + 5120); const LAS bf16* Vt = (const LAS bf16*)(bb + 10240);
#pragma unroll
        for (int st = 0; st < 2; ++st) {
            bf16x8 vf[4];
#pragma unroll
            for (int blk = 0; blk < 4; ++blk) { const LAS bf16* vp = Vt + (8 * (ql & 7) + 2 * blk + (ql >> 3)) * 72 + 32 * st + 4 * g; vf[blk] = cat4(*(const LAS s16x4*)vp, *(const LAS s16x4*)(vp + 16)); }
#pragma unroll
            for (int mp = 0; mp < 2; ++mp) {
                const LAS bf16* Ks = mp ? K2s : K1s;
                const bf16x8 ka = *(const LAS bf16x8*)(Ks + (32 * st + ql) * 40 + 8 * g), kb = *(const LAS bf16x8*)(Ks + (32 * st + 16 + ql) * 40 + 8 * g);
#pragma unroll
                for (int qg = 0; qg < 2; ++qg) {
                    const float mr = mref[mp][qg];
                    const f32x4 z = {-mr, -mr, -mr, -mr};
                    const f32x4 s0 = MFMA16(ka, qf[mp][qg], z), s1 = MFMA16(kb, qf[mp][qg], z);
                    float pv[8]; float ps = 0.f;
#pragma unroll
                    for (int e = 0; e < 4; ++e) { pv[e] = __builtin_amdgcn_exp2f(s0[e]); pv[4 + e] = __builtin_amdgcn_exp2f(s1[e]); ps += pv[e] + pv[4 + e]; }
                    lsum[mp][qg] += ps;
                    u32x4 w; w.x = pk2(pv[0], pv[1]); w.y = pk2(pv[2], pv[3]); w.z = pk2(pv[4], pv[5]); w.w = pk2(pv[6], pv[7]);
                    const bf16x8 pt = __builtin_bit_cast(bf16x8, w);
#pragma unroll
                    for (int blk = 0; blk < 4; ++blk) O[mp][qg][blk] = MFMA16(vf[blk], pt, O[mp][qg][blk]);
                }
            }
        }
        __syncthreads();
    }
#undef DA_STAGE
#undef DA_PREFETCH
    const float* ng = p->da_norm_g + l * 256 + 64 * h;
#pragma unroll
    for (int qg = 0; qg < 2; ++qg) {
        float l1 = lsum[0][qg]; l1 += __shfl_xor(l1, 16); l1 += __shfl_xor(l1, 32);
        float l2 = lsum[1][qg]; l2 += __shfl_xor(l2, 16); l2 += __shfl_xor(l2, 32);
        const float i1 = 1.f / l1, i2 = lam / l2;
        f32x4 o[4]; float ss = 0.f;
#pragma unroll
        for (int blk = 0; blk < 4; ++blk) { o[blk] = O[0][qg][blk] * i1 - O[1][qg][blk] * i2; ss += o[blk][0] * o[blk][0] + o[blk][1] * o[blk][1] + o[blk][2] * o[blk][2] + o[blk][3] * o[blk][3]; }
        ss += __shfl_xor(ss, 16); ss += __shfl_xor(ss, 32);
        const float rn = (1.f - lam_init) / sqrtf(ss * (1.f / 64.f) + 1e-6f);
        const int tq = (ctxq ? 0 : qb * 256) + wave * 32 + qg * 16 + ql;
        bf16* op = Pb + (size_t)((ctxq ? ctxbase : latbase) + tq) * NP + C_DAQ + 64 * h;
#pragma unroll
        for (int blk = 0; blk < 4; ++blk) { const f32x4 gg = *(const f32x4*)(ng + 16 * blk + 4 * g); const f32x4 y = o[blk] * rn * gg; u32x2 w; w.x = pk2(y[0], y[1]); w.y = pk2(y[2], y[3]); if (wr) *(u32x2*)(op + 16 * blk + 4 * g) = w; }
    }
}

DI void na_wave(PP p, bf16* Pb, const LAS float* bias, LAS bf16* Vt, bool ctxq, int bl, int h, int r, int cb, int cq0, bool wr) {
    const int lane = otid() & 63, g = lane >> 4, ql = lane & 15;
    const int latbase = bl * 2048, ctxbase = 32768 + bl * 256;
    const int cq = 16 * cb + ql;
    const int rowq = ctxq ? ctxbase + cq0 + ql : latbase + 64 * r + cq;
    const int r0 = min(max(r - 4, 0), 24), cs = cb == 0 ? 0 : (cb == 1 ? 8 : (cb == 2 ? 24 : 32)), c0 = min(max(cq - 8, 0), 48);
    bf16x8 qf[2];
    qf[0] = ld8(Pb + (size_t)rowq * NP + C_NAQ + 64 * h + 8 * g); qf[1] = ld8(Pb + (size_t)rowq * NP + C_NAQ + 64 * h + 32 + 8 * g);
    f32x4 O[4]; float mrun = -INFINITY, lsum = 0.f;
#pragma unroll
    for (int k = 0; k < 4; ++k) O[k] = (f32x4){0.f, 0.f, 0.f, 0.f};
    const int nsteps = ctxq ? 8 : 16;
    bf16x8 kfa[2][2], vpa[4], kfb[2][2], vpb[4];
#define NA_LOAD(st_, KF, VP) do { const int st__ = (st_); const bool loc__ = !ctxq && st__ < 8; const int kb__ = loc__ ? latbase + 64 * (r0 + st__) + cs : ctxbase + 32 * (ctxq ? st__ : st__ - 8); \
        _Pragma("unroll") for (int i = 0; i < 4; ++i) { const int piece = lane + 64 * i; VP[i] = ld8(Pb + (size_t)(kb__ + (piece >> 3)) * NP + C_NAV + 64 * h + 8 * (piece & 7)); } \
        _Pragma("unroll") for (int kt = 0; kt < 2; ++kt) { const bf16* kp = Pb + (size_t)(kb__ + 16 * kt + ql) * NP + C_NAK + 64 * h + 8 * g; KF[kt][0] = ld8(kp); KF[kt][1] = ld8(kp + 32); } } while (0)
#define NA_STEP(st_, KF, VP) do { const int st = (st_); const bool local = !ctxq && st < 8; \
        LDS_WAIT(); \
        _Pragma("unroll") for (int i = 0; i < 4; ++i) { const int piece = lane + 64 * i, key = piece >> 3, seg = piece & 7; \
            _Pragma("unroll") for (int e = 0; e < 8; ++e) Vt[(8 * e + seg) * 36 + key] = (bf16)VP[i][e]; } \
        f32x4 s[2]; \
        _Pragma("unroll") for (int kt = 0; kt < 2; ++kt) { const f32x4 z = {0.f, 0.f, 0.f, 0.f}; s[kt] = MFMA16(KF[kt][0], qf[0], z); s[kt] = MFMA16(KF[kt][1], qf[1], s[kt]); } \
        float mx = -INFINITY; \
        _Pragma("unroll") for (int kt = 0; kt < 2; ++kt) \
            _Pragma("unroll") for (int j = 0; j < 4; ++j) { \
                float v = s[kt][j] * (0.125f * LOG2E); \
                if (local) { const int col = cs + 16 * kt + 4 * g + j; const bool ok = col >= c0 && col < c0 + 16; \
                    const int bi = (r0 + st - r + 7) * 31 + min(max(col - cq + 15, 0), 30); \
                    v = ok ? v + bias[bi] : -INFINITY; } \
                s[kt][j] = v; mx = fmaxf(mx, v); } \
        mx = fmaxf(mx, __shfl_xor(mx, 16)); mx = fmaxf(mx, __shfl_xor(mx, 32)); \
        const float mnew = fmaxf(mrun, mx), alpha = __builtin_amdgcn_exp2f(mrun - mnew); mrun = mnew; \
        float pv[8]; float ps = 0.f; \
        _Pragma("unroll") for (int e = 0; e < 4; ++e) { pv[e] = __builtin_amdgcn_exp2f(s[0][e] - mnew); pv[4 + e] = __builtin_amdgcn_exp2f(s[1][e] - mnew); ps += pv[e] + pv[4 + e]; } \
        lsum = lsum * alpha + ps; \
        u32x4 w; w.x = pk2(pv[0], pv[1]); w.y = pk2(pv[2], pv[3]); w.z = pk2(pv[4], pv[5]); w.w = pk2(pv[6], pv[7]); \
        const bf16x8 pt = __builtin_bit_cast(bf16x8, w); \
        LDS_WAIT(); \
        _Pragma("unroll") for (int blk = 0; blk < 4; ++blk) { const LAS bf16* vp = Vt + (8 * (ql & 7) + 2 * blk + (ql >> 3)) * 36 + 4 * g; const bf16x8 vf = cat4(*(const LAS s16x4*)vp, *(const LAS s16x4*)(vp + 16)); \
            O[blk] = O[blk] * alpha; O[blk] = MFMA16(vf, pt, O[blk]); } } while (0)
    NA_LOAD(0, kfa, vpa);
    for (int st2 = 0; st2 < nsteps; st2 += 2) {
        NA_LOAD(st2 + 1, kfb, vpb);
        NA_STEP(st2, kfa, vpa);
        if (st2 + 2 < nsteps) NA_LOAD(st2 + 2, kfa, vpa);
        NA_STEP(st2 + 1, kfb, vpb);
    }
#undef NA_LOAD
#undef NA_STEP
    float lt = lsum; lt += __shfl_xor(lt, 16); lt += __shfl_xor(lt, 32);
    const float il = 1.f / lt;
    bf16* op = Pb + (size_t)rowq * NP + C_NAQ + 64 * h;
#pragma unroll
    for (int blk = 0; blk < 4; ++blk) { const f32x4 y = O[blk] * il; u32x2 w; w.x = pk2(y[0], y[1]); w.y = pk2(y[2], y[3]); if (wr) *(u32x2*)(op + 16 * blk + 4 * g) = w; }
}

DI int scan_row(int n, int dir, int latbase, int ctxbase) { const bool isc = n < 256; const int pos = isc ? n : n - 256; return (isc ? ctxbase : latbase) + (dir ? (isc ? 255 : 2047) - pos : pos); }
DI void mlstm_task(PP p, bf16* Pb, float* hbuf, LAS unsigned char* lds, int l, int bl, int h, int dir) {
    LAS bf16* Qs = (LAS bf16*)lds; LAS bf16* Ks = (LAS bf16*)(lds + 9216); LAS bf16* Vt = (LAS bf16*)(lds + 18432); LAS bf16* SW = (LAS bf16*)(lds + 29952);
    LAS bf16* Kt = (LAS bf16*)(lds + 39168); LAS bf16* Cb = (LAS bf16*)(lds + 48384); LAS float* Ct = (LAS float*)(lds + 59904); LAS float* NUM = (LAS float*)(lds + 80384);
    LAS float* tb = (LAS float*)(lds + 101120); LAS float* tib = tb + 2304; LAS float* tmt = tib + 2304; LAS float* csc = tmt + 2304;
    const int tid = otid(), wave = tid >> 6, lane = tid & 63, g = lane >> 4, ql = lane & 15;
    const int latbase = bl * 2048, ctxbase = 32768 + bl * 256;
    bf16* hout = (bf16*)hbuf + (size_t)dir * HROWS * 256;
    const int t = tid >> 3, seg = tid & 7;
    __syncthreads();
    for (int e = tid; e < 80 * 64; e += 512) Ct[e] = 0.f;
    for (int e = tid; e < 80 * 72; e += 512) Cb[e] = 0;
    for (int e = tid; e < 16 * 72; e += 512) Vt[64 * 72 + e] = (e < 64) ? (bf16)0x3F80 : (bf16)0;
    {
        const float gbi = p->ml_gate_b[l * 16 + (dir ? 8 : 0) + h], gbf = p->ml_gate_b[l * 16 + (dir ? 12 : 4) + h];
        for (int n = tid; n < 2304; n += 512) { const bf16* gp = Pb + (size_t)scan_row(n, dir, latbase, ctxbase) * NP + C_MLIF;
            tib[n] = bf2f(gp[(dir ? 8 : 0) + h]) + gbi; tb[n] = logsig(bf2f(gp[(dir ? 12 : 4) + h]) + gbf); }
    }
    __syncthreads();
    for (int c = wave; c < 36; c += 8) {
        const int n = 64 * c + lane; const float ib = tib[n]; float b = tb[n];
#pragma unroll
        for (int o = 1; o < 64; o <<= 1) { const float x = __shfl_up(b, o); if (lane >= o) b += x; }
        float pm = ib - b;
#pragma unroll
        for (int o = 1; o < 64; o <<= 1) { const float x = __shfl_up(pm, o); if (lane >= o) pm = fmaxf(pm, x); }
        const float bend = __shfl(b, 63); float km = bend - b + ib;
#pragma unroll
        for (int o = 1; o < 64; o <<= 1) km = fmaxf(km, __shfl_xor(km, o));
        tb[n] = b; tmt[n] = pm; if (lane == 0) { csc[4 * c] = bend; csc[4 * c + 1] = km; }
    }
    __syncthreads();
    if (tid == 0) { float mprev = 0.f; for (int c = 0; c < 36; ++c) { const float mnew = fmaxf(csc[4 * c] + mprev, csc[4 * c + 1]); csc[4 * c + 2] = mprev; csc[4 * c + 3] = mnew; mprev = mnew; } }
    __syncthreads();
    for (int n = tid; n < 2304; n += 512) { const float b = tb[n]; tmt[n] = fmaxf(b + csc[4 * (n >> 6) + 2], b + tmt[n]); }
    bf16x8 pq, pk, pv;
#define ML_PREF(c_) do { const bf16* rp = Pb + (size_t)scan_row(64 * (c_) + t, dir, latbase, ctxbase) * NP + 64 * h + 8 * seg; pq = ld8(rp + C_MLQ); pk = ld8(rp + C_MLK); pv = ld8(rp + C_MLV); } while (0)
#define ML_OUT(c_) do { const int n_ = 64 * (c_) + t; const float den = fmaxf(fabsf(NUM[t * 81 + 64]), __expf(-tmt[n_])); const float id = __builtin_amdgcn_rcpf(den); \
        bf16* op = hout + (size_t)scan_row(n_, dir, latbase, ctxbase) * 256 + 64 * h + 8 * seg; f32x4 o0, o1; \
        _Pragma("unroll") for (int e = 0; e < 4; ++e) { o0[e] = NUM[t * 81 + 8 * seg + e] * id; o1[e] = NUM[t * 81 + 8 * seg + 4 + e] * id; } \
        u32x4 w_; w_.x = pk2(o0[0], o0[1]); w_.y = pk2(o0[2], o0[3]); w_.z = pk2(o1[0], o1[1]); w_.w = pk2(o1[2], o1[3]); *(u32x4*)op = w_; } while (0)
    ML_PREF(0);
    for (int c = 0; c < 36; ++c) {
        if (c > 0) { ML_OUT(c - 1); for (int e = tid; e < 80 * 64; e += 512) Cb[(e >> 6) * 72 + (e & 63)] = (bf16)f2bf(Ct[e]); }
        {
            const int n = 64 * c + t; const float wk = __expf(csc[4 * c] - tb[n] + tib[n] - csc[4 * c + 3]);
            float qv[8], kv[8];
#pragma unroll
            for (int e = 0; e < 8; ++e) { qv[e] = bf2f((unsigned short)pq[e]) * 0.125f; kv[e] = bf2f((unsigned short)pk[e]) * wk; }
            u32x4 w; w.x = pk2(qv[0], qv[1]); w.y = pk2(qv[2], qv[3]); w.z = pk2(qv[4], qv[5]); w.w = pk2(qv[6], qv[7]);
            *(LAS u32x4*)(Qs + t * 72 + 8 * seg) = w; *(LAS bf16x8*)(Ks + t * 72 + 8 * seg) = pk;
#pragma unroll
            for (int e = 0; e < 8; ++e) { Vt[(8 * e + seg) * 72 + t] = (bf16)pv[e]; Kt[(8 * e + seg) * 72 + t] = (bf16)f2bf(kv[e]); }
        }
        __syncthreads();
        if (c + 1 < 36) ML_PREF(c + 1);
#pragma unroll
        for (int it = 0; it < 2; ++it) {
            const int tile = wave + 8 * it;
            const int tm = tile >> 2, ts = tile & 3; f32x4 a = {0.f, 0.f, 0.f, 0.f};
            a = mm16(Qs, 72, 16 * tm, Ks, 72, 16 * ts, 64, a, ql, g);
            const int sI = 16 * ts + ql; const float cs = tib[64 * c + sI] - tb[64 * c + sI];
#pragma unroll
            for (int j = 0; j < 4; ++j) { const int tt = 16 * tm + 4 * g + j; const float w = (sI <= tt) ? __expf(tb[64 * c + tt] - tmt[64 * c + tt] + cs) : 0.f; SW[tt * 72 + sI] = (bf16)f2bf(a[j] * w); }
        }
        __syncthreads();
#pragma unroll
        for (int it = 0; it < 3; ++it) {
            const int tile0 = wave + 8 * it; const bool valid = tile0 < 20; const int tile = valid ? tile0 : 19;
            const int tm = tile / 5, tv = tile % 5; f32x4 a1 = {0.f, 0.f, 0.f, 0.f}, a2 = {0.f, 0.f, 0.f, 0.f};
            a1 = mm16<0, 1>(SW, 72, 16 * tm, Vt, 72, 16 * tv, 64, a1, ql, g);
            a2 = mm16(Qs, 72, 16 * tm, Cb, 72, 16 * tv, 64, a2, ql, g);
#pragma unroll
            for (int j = 0; j < 4; ++j) { const int tt = 16 * tm + 4 * g + j; const float wi = __expf(tb[64 * c + tt] + csc[4 * c + 2] - tmt[64 * c + tt]); NUM[tt * 81 + 16 * tv + ql] = a1[j] + wi * a2[j]; }
        }
        {
            const float decay = __expf(csc[4 * c] + csc[4 * c + 2] - csc[4 * c + 3]);
#pragma unroll
            for (int it = 0; it < 3; ++it) {
                const int tile0 = wave + 8 * it; const bool valid = tile0 < 20; const int tile = valid ? tile0 : 19;
                const int tv = tile >> 2, td = tile & 3; f32x4 a = {0.f, 0.f, 0.f, 0.f};
                a = mm16<1, 1>(Vt, 72, 16 * tv, Kt, 72, 16 * td, 64, a, ql, g);
#pragma unroll
                for (int j = 0; j < 4; ++j) { const int idx = (16 * tv + 4 * g + j) * 64 + 16 * td + ql; const float nv = decay * Ct[idx] + a[j]; if (valid) Ct[idx] = nv; }
            }
        }
        __syncthreads();
    }
    ML_OUT(35);
#undef ML_PREF
#undef ML_OUT
}

DI void gla_task(PP p, bf16* Pb, float* hbuf, LAS unsigned char* lds, int l, int bl, int h, int dir) {
    LAS bf16* Qg = (LAS bf16*)lds; LAS bf16* Kg = (LAS bf16*)(lds + 5120); LAS bf16* Vt = (LAS bf16*)(lds + 10240); LAS bf16* ATT = (LAS bf16*)(lds + 19456);
    LAS bf16* Kt = (LAS bf16*)(lds + 28672); LAS bf16* Sb = (LAS bf16*)(lds + 33280); LAS float* St = (LAS float*)(lds + 38400);
    LAS float* Wa = (LAS float*)(lds + 46592); LAS float* ba = (LAS float*)(lds + 48640); LAS float* decv = (LAS float*)(lds + 48768);
    const int tid = otid(), wave = tid >> 6, lane = tid & 63, g = lane >> 4, ql = lane & 15;
    const int latbase = bl * 2048, ctxbase = 32768 + bl * 256;
    bf16* hout = (bf16*)hbuf + (size_t)(2 + dir) * HROWS * 256;
    __syncthreads();
    for (int e = tid; e < 64 * 32; e += 512) St[e] = 0.f;
    for (int e = tid; e < 64 * 40; e += 512) Sb[e] = 0;
    { const int r = tid >> 5, d = tid & 31; Wa[tid] = p->gla_w_a2[(size_t)((l * 2 + dir) * 16 + r) * 128 + 32 * h + d]; if (tid < 32) ba[tid] = p->gla_b_a[(l * 2 + dir) * 128 + 32 * h + tid]; }
    __syncthreads();
    float wa[16][4], bav[4];
#pragma unroll
    for (int r = 0; r < 16; ++r)
#pragma unroll
        for (int e = 0; e < 4; ++e) wa[r][e] = Wa[r * 32 + 4 * wave + e];
#pragma unroll
    for (int e = 0; e < 4; ++e) bav[e] = ba[4 * wave + e];
    const float qs = 0.17677669529663687f;
    bf16x8 pa0, pa1, pvv; u32x2 pq, pk;
#define GL_PREF(c_) do { const bf16* rp = Pb + (size_t)scan_row(64 * (c_) + lane, dir, latbase, ctxbase) * NP; \
        pa0 = ld8(rp + C_GLA + 16 * dir); pa1 = ld8(rp + C_GLA + 16 * dir + 8); pq = *(const u32x2*)(rp + C_GLQ + 32 * h + 4 * wave); pk = *(const u32x2*)(rp + C_GLK + 32 * h + 4 * wave); \
        pvv = ld8(Pb + (size_t)scan_row(64 * (c_) + (tid >> 3), dir, latbase, ctxbase) * NP + C_GLV + 64 * h + 8 * (tid & 7)); } while (0)
    GL_PREF(0);
    for (int c = 0; c < 36; ++c) {
        if (c > 0) { for (int e = tid; e < 64 * 32; e += 512) Sb[(e >> 5) * 40 + (e & 31)] = (bf16)f2bf(St[e]); }
        {
            float av[16];
#pragma unroll
            for (int e = 0; e < 8; ++e) { av[e] = bf2f((unsigned short)pa0[e]); av[8 + e] = bf2f((unsigned short)pa1[e]); }
            float bb[4];
#pragma unroll
            for (int e = 0; e < 4; ++e) { float z = bav[e];
#pragma unroll
                for (int r = 0; r < 16; ++r) z += av[r] * wa[r][e];
                bb[e] = logsig_fast(z) * (1.f / 16.f); }
#pragma unroll
            for (int o = 1; o < 64; o <<= 1) {
#pragma unroll
                for (int e = 0; e < 4; ++e) { const float x = __shfl_up(bb[e], o); if (lane >= o) bb[e] += x; } }
            const float qv[4] = {bflo(pq.x), bfhi(pq.x), bflo(pq.y), bfhi(pq.y)}, kv[4] = {bflo(pk.x), bfhi(pk.x), bflo(pk.y), bfhi(pk.y)};
            float qo[4], ko[4];
#pragma unroll
            for (int e = 0; e < 4; ++e) { const float be = __shfl(bb[e], 63); qo[e] = qv[e] * qs * __expf(bb[e]); ko[e] = kv[e] * __expf(-bb[e]);
                Kt[(4 * wave + e) * 72 + lane] = (bf16)f2bf(kv[e] * __expf(be - bb[e])); if (lane == 0) decv[4 * wave + e] = __expf(be); }
            u32x2 w; w.x = pk2(qo[0], qo[1]); w.y = pk2(qo[2], qo[3]); *(LAS u32x2*)(Qg + lane * 40 + 4 * wave) = w;
            w.x = pk2(ko[0], ko[1]); w.y = pk2(ko[2], ko[3]); *(LAS u32x2*)(Kg + lane * 40 + 4 * wave) = w;
            const int tt = tid >> 3, seg = tid & 7;
#pragma unroll
            for (int e = 0; e < 8; ++e) Vt[(8 * e + seg) * 72 + tt] = (bf16)pvv[e];
        }
        __syncthreads();
        if (c + 1 < 36) GL_PREF(c + 1);
#pragma unroll
        for (int it = 0; it < 2; ++it) {
            const int tile = wave + 8 * it;
            const int tm = tile >> 2, ts = tile & 3; f32x4 a = {0.f, 0.f, 0.f, 0.f};
            a = mm16(Qg, 40, 16 * tm, Kg, 40, 16 * ts, 32, a, ql, g);
            const int sI = 16 * ts + ql;
#pragma unroll
            for (int j = 0; j < 4; ++j) { const int tt = 16 * tm + 4 * g + j; ATT[tt * 72 + sI] = (bf16)f2bf(sI <= tt ? a[j] : 0.f); }
        }
        __syncthreads();
#pragma unroll
        for (int it = 0; it < 2; ++it) {
            const int tile = wave + 8 * it;
            const int tm = tile >> 2, tv = tile & 3; f32x4 a = {0.f, 0.f, 0.f, 0.f};
            a = mm16<0, 1>(ATT, 72, 16 * tm, Vt, 72, 16 * tv, 64, a, ql, g);
            a = mm16(Qg, 40, 16 * tm, Sb, 40, 16 * tv, 32, a, ql, g);
#pragma unroll
            for (int j = 0; j < 4; ++j) { const int tt = 16 * tm + 4 * g + j; hout[(size_t)scan_row(64 * c + tt, dir, latbase, ctxbase) * 256 + 64 * h + 16 * tv + ql] = (bf16)f2bf(a[j]); }
        }
        {
            const int tv = wave >> 1, td = wave & 1; f32x4 a = {0.f, 0.f, 0.f, 0.f};
            a = mm16<1, 0>(Vt, 72, 16 * tv, Kt, 72, 16 * td, 64, a, ql, g);
            const int d = 16 * td + ql; const float dec = decv[d];
#pragma unroll
            for (int j = 0; j < 4; ++j) { const int idx = (16 * tv + 4 * g + j) * 32 + d; St[idx] = dec * St[idx] + a[j]; }
        }
        __syncthreads();
    }
#undef GL_PREF
}

DI void mixers_phase(PP p, LAS unsigned char* lds, int l, bool ctx_out, bool wr, int mask, int qidx) {
    bf16* Pb = (bf16*)(p->ws + WS_BIG); float* hbuf = (float*)(p->ws + WS_HBUF);
    const int n_da = 512, n_dac = ctx_out ? 64 : 0, n_na = 1024, n_nac = ctx_out ? 128 : 0;
    const int n_rest = n_da + n_dac + n_na + n_nac;
    for (int i = obid(); i < 256; i += ogrid()) {
        if (i < 128) { if (mask & 1) mlstm_task(p, Pb, hbuf, lds, l, i >> 3, (i >> 1) & 3, i & 1); }
        else { const int i2 = i - 128; if (mask & 2) gla_task(p, Pb, hbuf, lds, l, i2 >> 3, (i2 >> 1) & 3, i2 & 1); }
    }
    asm volatile("" ::: "memory");
    const float lam_init = 0.8f - 0.6f * expf(-0.3f * (float)l);
    float lam;
    { const float* dl = p->da_lambda + l * 128; float s1 = 0.f, s2 = 0.f;
#pragma unroll 1
        for (int i = 0; i < 32; ++i) { s1 += dl[i] * dl[32 + i]; s2 += dl[64 + i] * dl[96 + i]; }
        lam = expf(s1) - expf(s2) + lam_init; }
    unsigned* ctr = (unsigned*)(p->ws + WS_BAR) + 3520 + qidx;
    volatile LAS int* slot = (volatile LAS int*)(lds + LDS_BYTES - 64 + 32);
    for (;;) {
        __syncthreads();
        if (otid() == 0) *slot = (int)__hip_atomic_fetch_add(ctr, 1u, __ATOMIC_RELAXED, __HIP_MEMORY_SCOPE_AGENT);
        __syncthreads();
        int i = *slot;
        if (i >= n_rest) break;
        if (i < n_da) { if (mask & 4) da_item(p, Pb, lds, l, false, i >> 5, (i >> 3) & 3, i & 7, lam, lam_init, wr); continue; } i -= n_da;
        if (i < n_dac) { if (mask & 4) da_item(p, Pb, lds, l, true, i >> 2, i & 3, 0, lam, lam_init, wr); continue; } i -= n_dac;
        if (!(mask & 8)) continue;
        const int tid = otid(), wave = tid >> 6;
        LAS float* bias = (LAS float*)lds; LAS bf16* Vt = (LAS bf16*)(lds + 2048 + wave * 5120);
        if (i < n_na) {
            const int bl = i >> 6, h = (i >> 4) & 3, rp = i & 15;
            __syncthreads();
            for (int e = tid; e < 465; e += 512) bias[e] = p->na_rpb[(size_t)((l * 4 + h) * 15) * 31 + e] * LOG2E;
            __syncthreads();
            na_wave(p, Pb, bias, Vt, false, bl, h, 2 * rp + (wave >> 2), wave & 3, 0, wr);
            continue;
        }
        i -= n_na;
        { const int bl = i >> 3, h = (i >> 1) & 3, hf = i & 1; __syncthreads(); na_wave(p, Pb, bias, Vt, true, bl, h, 0, 0, 128 * hf + 16 * wave, wr); }
    }
}

DI void finish_phase(PP p, int l, bool ctx_out) {
    bf16* Pb = (bf16*)(p->ws + WS_BIG); const float* hbuf = (const float*)(p->ws + WS_HBUF);
    const int wave = otid() >> 6, lane = otid() & 63;
    const int gw = obid() * 8 + wave, NGW = ogrid() * 8;
    const int nrows = ctx_out ? HROWS : 32768;
    for (int gi = gw; gi < nrows / 4; gi += NGW) {
        const int r0 = gi * 4;
#pragma unroll
        for (int br = 0; br < 2; ++br) {
            f32x4 v[4]; u32x2 gw2[4];
            const bf16* hf = (const bf16*)hbuf + (size_t)(2 * br) * HROWS * 256 + (size_t)r0 * 256 + 4 * lane; const bf16* hb = hf + (size_t)HROWS * 256;
            bf16* gp = Pb + (size_t)r0 * NP + (br == 0 ? C_MLO : C_GLG) + 4 * lane;
#pragma unroll
            for (int k = 0; k < 4; ++k) { const u32x2 a_ = *(const u32x2*)(hf + k * 256), b_ = *(const u32x2*)(hb + k * 256); v[k] = (f32x4){bflo(a_.x) + bflo(b_.x), bfhi(a_.x) + bfhi(b_.x), bflo(a_.y) + bflo(b_.y), bfhi(a_.y) + bfhi(b_.y)}; gw2[k] = *(const u32x2*)(gp + (size_t)k * NP); }
            const f32x4 gg = *(const f32x4*)((br == 0 ? p->ml_norm_g : p->gla_norm_g) + l * 256 + 4 * lane);
#pragma unroll
            for (int k = 0; k < 4; ++k) {
                f32x4 x = v[k];
                float s = (x[0] + x[1]) + (x[2] + x[3]), q = (x[0] * x[0] + x[1] * x[1]) + (x[2] * x[2] + x[3] * x[3]);
                s += __shfl_xor(s, 1); q += __shfl_xor(q, 1); s += __shfl_xor(s, 2); q += __shfl_xor(q, 2); s += __shfl_xor(s, 4); q += __shfl_xor(q, 4); s += __shfl_xor(s, 8); q += __shfl_xor(q, 8);
                float ms = q * (1.f / 64.f);
                if (br == 0) { const float mean = s * (1.f / 64.f); x = x - mean; ms = fmaxf(ms - mean * mean, 0.f); }
                const float rn = __builtin_amdgcn_rsqf(ms + 1e-6f);
                const float gt[4] = {bflo(gw2[k].x), bfhi(gw2[k].x), bflo(gw2[k].y), bfhi(gw2[k].y)};
                float y[4];
#pragma unroll
                for (int e = 0; e < 4; ++e) { const float a = sigm(gt[e]); y[e] = (br == 0 ? a : a * gt[e]) * x[e] * rn * gg[e]; }
                u32x2 w; w.x = pk2(y[0], y[1]); w.y = pk2(y[2], y[3]); *(u32x2*)(gp + (size_t)k * NP) = w;
            }
        }
    }
}

#define XB_TMO      128
#define XB_XCNT(j)  (256  + 64 * (j))
#define XB_XSUB(j)  (1280 + 64 * (j))
#define XB_XGEN(j)  (2304 + 64 * (j))
#define XB_TOP      3328
#define XB_TOPGEN   3392
#define XCD_BAR_WORDS 3456
#define XB_SPIN_CAP (1u << 23)

__device__ __forceinline__ unsigned xb_ld(unsigned* p)              { return __hip_atomic_load(p, __ATOMIC_RELAXED, __HIP_MEMORY_SCOPE_AGENT); }
__device__ __forceinline__ unsigned xb_add(unsigned* p, unsigned v) { return __hip_atomic_fetch_add(p, v, __ATOMIC_RELAXED, __HIP_MEMORY_SCOPE_AGENT); }
__device__ __forceinline__ unsigned xb_xcc_id() { return (unsigned)__builtin_amdgcn_s_getreg((3 << 11) | 20) & 0xFu; }
#define XB_SPIN(cond, bar) do { unsigned _sp = 0; while (cond) { __builtin_amdgcn_s_sleep(1); \
    if ((++_sp & 255u) == 0u) { if (xb_ld(&(bar)[XB_TMO])) break; if (_sp > XB_SPIN_CAP) { atomicAdd(&(bar)[XB_TMO], 1u); break; } } } } while (0)

struct XcdBarrier {
    unsigned* bar; unsigned x;
    volatile LAS unsigned* st;
};

__device__ __forceinline__ XcdBarrier xcd_barrier_post(unsigned* bar, volatile LAS unsigned* st) {
    XcdBarrier b; b.bar = bar; b.x = xb_xcc_id(); b.st = st;
    if (threadIdx.x == 0) (void)xb_add(&bar[XB_XCNT(b.x)], 1u);
    return b;
}
__device__ __forceinline__ void xcd_barrier_complete(unsigned* bar, unsigned x, unsigned& nloc, unsigned& nx) {
    const unsigned G = gridDim.x * gridDim.y * gridDim.z;
    unsigned sum, cnt, mine, sp = 0u;
    for (;;) {
        sum = 0u; cnt = 0u; mine = 0u;
#pragma unroll
        for (unsigned j = 0; j < 16; ++j) { const unsigned c = xb_ld(&bar[XB_XCNT(j)]); sum += c; cnt += (c > 0u) ? 1u : 0u; mine = (j == x) ? c : mine; }
        if (sum == G) break;
        __builtin_amdgcn_s_sleep(1);
        if ((++sp & 255u) == 0u) { if (xb_ld(&bar[XB_TMO])) break; if (sp > XB_SPIN_CAP) { atomicAdd(&bar[XB_TMO], 1u); break; } }
    }
    nloc = mine > 0u ? mine : 1u; nx = cnt > 0u ? cnt : 1u;
}

__device__ __forceinline__ void xcd_barrier(const XcdBarrier& b) {
    asm volatile("s_waitcnt vmcnt(0)" ::: "memory");
    __syncthreads();
    if (threadIdx.x == 0) {
        unsigned* bar = b.bar;
        __builtin_amdgcn_s_waitcnt(0);
        unsigned nloc = b.st[0], nx = b.st[1];
        if (nloc == 0u) { xcd_barrier_complete(bar, b.x, nloc, nx); b.st[0] = nloc; b.st[1] = nx; }
        const unsigned old = xb_add(&bar[XB_XSUB(b.x)], 1u);
        const unsigned gen = old / nloc;
        if (old + 1u == (gen + 1u) * nloc) {
            __builtin_amdgcn_fence(__ATOMIC_RELEASE, "agent");
            asm volatile("s_waitcnt vmcnt(0)" ::: "memory");
            const unsigned og = xb_add(&bar[XB_TOP], 1u);
            const unsigned tg = og / nx;
            if (og + 1u == (tg + 1u) * nx) xb_add(&bar[XB_TOPGEN], 1u);
            else XB_SPIN(xb_ld(&bar[XB_TOPGEN]) == tg, bar);
            __builtin_amdgcn_fence(__ATOMIC_ACQUIRE, "agent");
            xb_add(&bar[XB_XGEN(b.x)], 1u);
            asm volatile("s_waitcnt vmcnt(0)" ::: "memory");
        } else {
            XB_SPIN(xb_ld(&bar[XB_XGEN(b.x)]) == gen, bar);
            __builtin_amdgcn_fence(__ATOMIC_ACQUIRE, "agent");
            asm volatile("s_waitcnt vmcnt(0)" ::: "memory");
        }
    }
    __syncthreads();
}


__global__ void __launch_bounds__(512) fwd_megakernel(Params pv, int ph_lo, int ph_hi) {
    extern __shared__ __attribute__((aligned(16))) unsigned char lds_raw[];
    LAS unsigned char* lds = (LAS unsigned char*)lds_raw;
    cg::grid_group grid = cg::this_grid();
    PP p = (PP)__builtin_amdgcn_kernarg_segment_ptr();
    if (ph_hi > 34) ph_hi = 34;
    volatile LAS unsigned* bst = (volatile LAS unsigned*)(lds + LDS_BYTES - 64);
    if (threadIdx.x < 2) bst[threadIdx.x] = 0u;
    __syncthreads();
    if (blockIdx.x == 0) { unsigned* bw = (unsigned*)(p->ws + WS_BAR); for (int i = threadIdx.x; i < 4096; i += 512) __hip_atomic_store(bw + i, 0u, __ATOMIC_RELAXED, __HIP_MEMORY_SCOPE_AGENT); __threadfence(); }
    grid.sync();
    XcdBarrier bar = xcd_barrier_post((unsigned*)(p->ws + WS_BAR), bst);
#if PROBE_MODE
    LAS float* TT = (LAS float*)(lds + 131072 + 1024);
    if (threadIdx.x == 0) TT[0] = 0.f;
#endif
#pragma unroll 1
    for (int ph = ph_lo; ph < ph_hi; ++ph) {
#if PROBE_MODE
        if (threadIdx.x == 0) *(LAS unsigned long long*)(TT + 2) = __builtin_amdgcn_s_memrealtime();
#endif
        bf16* hmod = (bf16*)(p->ws + WS_HMOD); bf16* big = (bf16*)(p->ws + WS_BIG);
        if (ph == 0) p0_prologue(p, lds);
        else if (ph == 1) rows_phase(p, 0, RALL, 0, 0, true, 0, 0, 1, false);
        else {
            const int l = (ph - 2) >> 4, k = (ph - 2) & 15;
            const bool ctx_out = (l == 0);
            const int nrow = ctx_out ? RALL : RLAT, npan = nrow / 256;
            if (k == 0 || k == 13) {
                const int s = k == 0 ? 0 : 1;
                pg8::ProbFfnIn q; q.K = 1024; q.lda = 1024; q.o.init(k == 0 ? 288 : npan, 22); q.A = hmod; q.Bt = (const bf16*)(p->ws + WS_WIN) + (size_t)(l * 2 + s) * 5632 * 1024; q.act = big;
                GEMM_REP(q);
            } else if (k == 1 || k == 11 || k == 14) {
                pg8::ProbRes q; q.prm = p; q.layer = l; q.first = (l == 0 && k == 1); q.lnidx = k == 1 ? (l - 1) * 3 + 2 : (k == 11 ? l * 3 : l * 3 + 1);
                if (k == 11) { q.K = 1024; q.lda = 1024; q.A = hmod; q.Bt = (const bf16*)(p->ws + WS_WO) + (size_t)l * 1024 * 1024; q.gidx = 5; q.coef = 1.0f; }
                else { q.K = DFF; q.lda = DFF; q.A = big; q.Bt = (const bf16*)(p->ws + WS_WOUTF) + (size_t)(l * 2 + (k == 1 ? 0 : 1)) * 1024 * DFF; q.gidx = k == 1 ? 2 : 8; q.coef = 0.5f; }
                q.o.init(k == 1 ? 288 : npan, 4); q.dry = 0; q.fin = (l == 1 && k == 14);
                { int nrep = REPG ? 2 : 1; asm volatile("" : "+s"(nrep));
_Pragma("unroll 1") for (int rep = 0; rep < nrep; ++rep) { q.dry = (rep + 1 < nrep); pg8::gemm_phase(lds, q); if (rep + 1 < nrep) xcd_barrier(bar); } }
            } else if (k == 2) rows_phase(p, 1, RALL, l, 0, true, l, 3, 4, false);
            else if (k == 12) rows_phase(p, 1, nrow, l, 1, true, l, 6, 7, false);
            else if (k == 15) rows_phase(p, 1, nrow, l, 2, l == 0, 1, 0, 1, l == 1);
            else {
                const int half = (k - 3) >> 2, kk = (k - 3) & 3;
                if (kk == 0) { pg8::ProbMix q; q.K = 1024; q.lda = 1024; q.o.init(144, 30); q.A = hmod; q.Bt = (const bf16*)(p->ws + WS_WMIX) + (size_t)l * NP * 1024; q.Pb = big; q.half = half; GEMM_REP(q); }
                else if (kk == 1) { if (DRY_MASK) { int dm = DRY_MASK; asm volatile("" : "+s"(dm)); mixers_phase(p, lds, l, ctx_out, dm > 100, dm, 8 + l * 2 + half); grid.sync(); } mixers_phase(p, lds, l, ctx_out, true, 15, l * 2 + half); }
                else if (kk == 2) finish_phase(p, l, ctx_out);
                else { pg8::ProbMerge q; q.K = 256; q.lda = NP; q.o.init(ctx_out ? 144 : 128, 4); q.Pb = big; q.Wb = (const bf16*)(p->ws + WS_WB) + (size_t)l * 4 * 1024 * 256; q.merged = hmod; q.half = half; GEMM_REP(q); }
            }
        }
        if (ph + 1 < ph_hi) xcd_barrier(bar);
#if PROBE_MODE
        if (threadIdx.x == 0) { int cat = 0; if (ph == 0) cat = 0; else if (ph == 1) cat = 1; else { const int k = (ph - 2) & 15; cat = (k == 0 || k == 13) ? 2 : ((k == 1 || k == 11 || k == 14) ? 3 : ((k == 2 || k == 12 || k == 15) ? 1 : (((k - 3) & 3) == 0 ? 4 : (((k - 3) & 3) == 1 ? 5 : (((k - 3) & 3) == 2 ? 6 : 7))))); }
            if (cat == PROBE_A) TT[0] += (float)(__builtin_amdgcn_s_memrealtime() - *(LAS unsigned long long*)(TT + 2)) * 0.01f; }
#endif
    }
#if PROBE_MODE
    xcd_barrier(bar);
    if (blockIdx.x == 0) { __syncthreads(); const float ta = TT[0]; for (int i = threadIdx.x; i < (1 << 20); i += 512) p->out[(1 << 20) + i] += ta * 1e-5f; }
#endif
}

extern "C" void kernel_launch(void* const* d_in, const int* in_sizes, int n_in, void* d_out, int out_size, void* d_ws, size_t ws_size, hipStream_t stream) {
    static int grid = 0;
    if (grid == 0) {
        int dev = 0, cus = 0, per_cu = 0;
        hipGetDevice(&dev);
        hipDeviceGetAttribute(&cus, hipDeviceAttributeMultiprocessorCount, dev);
        hipFuncSetAttribute((const void*)fwd_megakernel, hipFuncAttributeMaxDynamicSharedMemorySize, LDS_BYTES);
        hipOccupancyMaxActiveBlocksPerMultiprocessor(&per_cu, (const void*)fwd_megakernel, 512, LDS_BYTES);
        if (per_cu < 1) per_cu = 1;
        grid = cus * per_cu;
        if (ws_size < WS_END) fprintf(stderr, "kernel_launch: workspace too small: %zu < %zu\n", ws_size, (size_t)WS_END);
    }
    Params p{};
    const float** pp = (const float**)&p;
    for (int i = 0; i < 21; ++i) pp[i] = (const float*)d_in[i];
    p.out = (float*)d_out; p.ws = (unsigned char*)d_ws;
    int lo = 0, hi = 1000;
    void* args[] = {&p, &lo, &hi};
    hipError_t e = hipLaunchCooperativeKernel((const void*)fwd_megakernel, dim3(grid), dim3(512), args, LDS_BYTES, stream);
    if (e != hipSuccess) fprintf(stderr, "cooperative launch failed: %s (grid %d)\n", hipGetErrorString(e), grid);
}
```
